# Optimizing an MI355X kernel written in HIP

```python
import math
import jax, jax.numpy as jnp
from jax import lax
import numpy as np

D_MODEL = 2048
BATCH = 4
SEQ = 4096
DEPTH = 4

N_MIXERS = 3
EPS = 1e-6
POOL_WINDOWS = (2, 4, 8, 16)
N_POOL_GROUPS = len(POOL_WINDOWS)
POOL_GROUP = D_MODEL // N_POOL_GROUPS
SWA_HEADS = 32
SWA_KV_HEADS = 4
SWA_GROUP = SWA_HEADS // SWA_KV_HEADS
SWA_HEAD_DIM = D_MODEL // SWA_HEADS
SWA_WINDOW = 128
BLOCK = 128
MLA_HEADS = 16
MLA_NOPE = 128
MLA_ROPE = 64
MLA_V = 128
MLA_Q_RANK = 512
MLA_KV_RANK = 512
ROPE_THETA = 10000.0
D_FF = 5632
CONV_W = 3

kernel_name = "hybrid_pool_swa_mla_convglu_encoder"


def rmsnorm(x, g):
    xf = x.astype(jnp.float32)
    y = xf * lax.rsqrt(jnp.mean(xf * xf, axis=-1, keepdims=True) + EPS)
    return (y * g.astype(jnp.float32)).astype(x.dtype)


def alibi_slopes(n):
    return jnp.asarray(2.0 ** (-8.0 * np.arange(1, n + 1) / n), dtype=jnp.float32)


def rope_tables(positions, dim):
    inv = ROPE_THETA ** (-jnp.arange(0, dim, 2, dtype=jnp.float32) / dim)
    ang = positions.astype(jnp.float32)[:, None] * inv[None, :]
    return jnp.cos(ang), jnp.sin(ang)


def apply_rope(x, cos, sin):
    x1, x2 = jnp.split(x.astype(jnp.float32), 2, axis=-1)
    return jnp.concatenate([x1 * cos - x2 * sin, x2 * cos + x1 * sin], axis=-1).astype(x.dtype)


def pool_mixer(h, w_groups, scale):
    B, S, D = h.shape
    hf = h.astype(jnp.float32).reshape(B, S, N_POOL_GROUPS, POOL_GROUP)
    csum = jnp.concatenate(
        [jnp.zeros((B, 1, N_POOL_GROUPS, POOL_GROUP), jnp.float32), jnp.cumsum(hf, axis=1)],
        axis=1)
    left = np.array([w // 2 for w in POOL_WINDOWS], dtype=np.int32)
    right = np.array([w - 1 - w // 2 for w in POOL_WINDOWS], dtype=np.int32)
    t = jnp.arange(S, dtype=jnp.int32)[:, None]
    hi = jnp.clip(t + right[None, :] + 1, 0, S)
    lo = jnp.clip(t - left[None, :], 0, S)
    g_idx = jnp.arange(N_POOL_GROUPS)[None, :]
    win_sum = csum[:, hi, g_idx] - csum[:, lo, g_idx]
    count = (hi - lo).astype(jnp.float32)[None, :, :, None]
    pooled = (win_sum / count - hf).astype(h.dtype)
    y = jnp.einsum('bsgc,gcd->bsgd', pooled, w_groups).reshape(B, S, D)
    return y * scale


def swa_mixer(h, positions, w_qkv, q_gain, k_gain, sinks, w_o):
    B, S, D = h.shape
    nq = SWA_HEADS * SWA_HEAD_DIM
    nkv = SWA_KV_HEADS * SWA_HEAD_DIM
    qkv = h @ w_qkv
    q = qkv[..., :nq].reshape(B, S, SWA_KV_HEADS, SWA_GROUP, SWA_HEAD_DIM)
    k = qkv[..., nq:nq + nkv].reshape(B, S, SWA_KV_HEADS, SWA_HEAD_DIM)
    v = qkv[..., nq + nkv:].reshape(B, S, SWA_KV_HEADS, SWA_HEAD_DIM)
    q = rmsnorm(q, q_gain) * (SWA_HEAD_DIM ** -0.5)
    k = rmsnorm(k, k_gain)
    pad = SWA_WINDOW
    span = BLOCK + 2 * SWA_WINDOW
    k_pad = jnp.pad(k, ((0, 0), (pad, pad), (0, 0), (0, 0)))
    v_pad = jnp.pad(v, ((0, 0), (pad, pad), (0, 0), (0, 0)))
    pos_pad = jnp.pad(positions, (pad, pad))
    valid_pad = jnp.pad(jnp.ones((S,), dtype=bool), (pad, pad))
    slopes = alibi_slopes(SWA_HEADS).reshape(SWA_KV_HEADS, SWA_GROUP)
    sink = sinks.astype(jnp.float32).reshape(SWA_KV_HEADS, SWA_GROUP)[None, :, :, None]

    def block(j):
        start = j * BLOCK
        qb = lax.dynamic_slice_in_dim(q, start, BLOCK, axis=1)
        kb = lax.dynamic_slice_in_dim(k_pad, start, span, axis=1)
        vb = lax.dynamic_slice_in_dim(v_pad, start, span, axis=1)
        pq = lax.dynamic_slice_in_dim(positions, start, BLOCK)
        pk = lax.dynamic_slice_in_dim(pos_pad, start, span)
        ok = lax.dynamic_slice_in_dim(valid_pad, start, span)
        qi = start + jnp.arange(BLOCK)
        ki = start - SWA_WINDOW + jnp.arange(span)
        in_win = (jnp.abs(qi[:, None] - ki[None, :]) <= SWA_WINDOW) & ok[None, :]
        s = jnp.einsum('bqkgd,bskd->bkgqs', qb, kb).astype(jnp.float32)
        dist = jnp.abs(pq[:, None] - pk[None, :]).astype(jnp.float32)
        s = s - slopes[:, :, None, None] * dist
        s = jnp.where(in_win, s, -jnp.inf)
        m = jnp.maximum(jnp.max(s, axis=-1), sink)
        p = jnp.exp(s - m[..., None])
        denom = jnp.sum(p, axis=-1) + jnp.exp(sink - m)
        p = (p / denom[..., None]).astype(vb.dtype)
        return jnp.einsum('bkgqs,bskd->bqkgd', p, vb)

    o = lax.map(block, jnp.arange(S // BLOCK))
    o = jnp.transpose(o, (1, 0, 2, 3, 4, 5)).reshape(B, S, nq)
    return o @ w_o


def mla_mixer(h, positions, w_down, q_a_gain, kv_a_gain, w_uq, w_ukv,
              qn_gain, qr_gain, kn_gain, kr_gain, w_o):
    B, S, D = h.shape
    d = h @ w_down
    cq = rmsnorm(d[..., :MLA_Q_RANK], q_a_gain)
    ckv = rmsnorm(d[..., MLA_Q_RANK:MLA_Q_RANK + MLA_KV_RANK], kv_a_gain)
    k_pe = d[..., MLA_Q_RANK + MLA_KV_RANK:]
    q = (cq @ w_uq).reshape(B, S, MLA_HEADS, MLA_NOPE + MLA_ROPE)
    kv = (ckv @ w_ukv).reshape(B, S, MLA_HEADS, MLA_NOPE + MLA_V)
    q_nope = rmsnorm(q[..., :MLA_NOPE], qn_gain)
    q_pe = rmsnorm(q[..., MLA_NOPE:], qr_gain)
    k_nope = rmsnorm(kv[..., :MLA_NOPE], kn_gain)
    v = kv[..., MLA_NOPE:]
    k_pe = rmsnorm(k_pe, kr_gain)
    cos, sin = rope_tables(positions, MLA_ROPE)
    q_pe = apply_rope(q_pe, cos[:, None, :], sin[:, None, :])
    k_pe = apply_rope(k_pe, cos, sin)
    scale = (MLA_NOPE + MLA_ROPE) ** -0.5
    q_nope = q_nope * scale
    q_pe = q_pe * scale

    def block(j):
        start = j * BLOCK
        qn = lax.dynamic_slice_in_dim(q_nope, start, BLOCK, axis=1)
        qp = lax.dynamic_slice_in_dim(q_pe, start, BLOCK, axis=1)
        s = (jnp.einsum('bqhd,bshd->bhqs', qn, k_nope).astype(jnp.float32)
             + jnp.einsum('bqhr,bsr->bhqs', qp, k_pe).astype(jnp.float32))
        p = jax.nn.softmax(s, axis=-1).astype(v.dtype)
        return jnp.einsum('bhqs,bshd->bqhd', p, v)

    o = lax.map(block, jnp.arange(S // BLOCK))
    o = jnp.transpose(o, (1, 0, 2, 3, 4)).reshape(B, S, MLA_HEADS * MLA_V)
    return o @ w_o


def conv_glu(h, w_in, conv_w, conv_b, w_out):
    u = h @ w_in
    g, val = u[..., :D_FF], u[..., D_FF:]
    gp = jnp.pad(g, ((0, 0), (1, 1), (0, 0)))
    g = gp[:, :-2] * conv_w[0] + gp[:, 1:-1] * conv_w[1] + gp[:, 2:] * conv_w[2] + conv_b
    return (jax.nn.silu(g) * val) @ w_out


def setup_inputs(seed: int = 0) -> dict:
    key = jax.random.key(seed)
    ks = iter(jax.random.split(key, 40))
    f32 = jnp.float32
    n_pool = (DEPTH + 2) // 3
    n_swa = (DEPTH + 1) // 3
    n_mla = DEPTH // 3
    res = (2.0 * DEPTH) ** -0.5

    def w(shape, fan_in, gain=1.0):
        return jax.random.normal(next(ks), shape, f32) * (gain * fan_in ** -0.5)

    def gain(shape):
        return 1.0 + 0.02 * jax.random.normal(next(ks), shape, f32)

    x = jax.random.normal(next(ks), (BATCH, SEQ, D_MODEL), f32)
    positions = jnp.arange(SEQ, dtype=jnp.int32)
    norm_mix_g = gain((DEPTH, D_MODEL))
    norm_ffn_g = gain((DEPTH, D_MODEL))
    pool_w = w((n_pool, N_POOL_GROUPS, POOL_GROUP, POOL_GROUP), POOL_GROUP, res)
    pool_scale = 1.0 + 0.1 * jax.random.normal(next(ks), (n_pool, D_MODEL), f32)
    n_qkv = SWA_HEADS * SWA_HEAD_DIM + 2 * SWA_KV_HEADS * SWA_HEAD_DIM
    swa_w_qkv = w((n_swa, D_MODEL, n_qkv), D_MODEL)
    swa_q_gain = gain((n_swa, SWA_HEAD_DIM))
    swa_k_gain = gain((n_swa, SWA_HEAD_DIM))
    swa_sinks = 0.5 * jax.random.normal(next(ks), (n_swa, SWA_HEADS), f32)
    swa_w_o = w((n_swa, SWA_HEADS * SWA_HEAD_DIM, D_MODEL), SWA_HEADS * SWA_HEAD_DIM, res)
    mla_w_down = w((n_mla, D_MODEL, MLA_Q_RANK + MLA_KV_RANK + MLA_ROPE), D_MODEL)
    mla_q_a_gain = gain((n_mla, MLA_Q_RANK))
    mla_kv_a_gain = gain((n_mla, MLA_KV_RANK))
    mla_w_uq = w((n_mla, MLA_Q_RANK, MLA_HEADS * (MLA_NOPE + MLA_ROPE)), MLA_Q_RANK)
    mla_w_ukv = w((n_mla, MLA_KV_RANK, MLA_HEADS * (MLA_NOPE + MLA_V)), MLA_KV_RANK)
    mla_qn_gain = gain((n_mla, MLA_NOPE))
    mla_qr_gain = gain((n_mla, MLA_ROPE))
    mla_kn_gain = gain((n_mla, MLA_NOPE))
    mla_kr_gain = gain((n_mla, MLA_ROPE))
    mla_w_o = w((n_mla, MLA_HEADS * MLA_V, D_MODEL), MLA_HEADS * MLA_V, res)
    ffn_w_in = w((DEPTH, D_MODEL, 2 * D_FF), D_MODEL)
    ffn_conv_w = w((DEPTH, CONV_W, D_FF), CONV_W)
    ffn_conv_b = 0.02 * jax.random.normal(next(ks), (DEPTH, D_FF), f32)
    ffn_w_out = w((DEPTH, D_FF, D_MODEL), D_FF, res)
    return {
        "x": x, "positions": positions,
        "norm_mix_g": norm_mix_g, "norm_ffn_g": norm_ffn_g,
        "pool_w": pool_w, "pool_scale": pool_scale,
        "swa_w_qkv": swa_w_qkv, "swa_q_gain": swa_q_gain, "swa_k_gain": swa_k_gain,
        "swa_sinks": swa_sinks, "swa_w_o": swa_w_o,
        "mla_w_down": mla_w_down, "mla_q_a_gain": mla_q_a_gain, "mla_kv_a_gain": mla_kv_a_gain,
        "mla_w_uq": mla_w_uq, "mla_w_ukv": mla_w_ukv,
        "mla_qn_gain": mla_qn_gain, "mla_qr_gain": mla_qr_gain,
        "mla_kn_gain": mla_kn_gain, "mla_kr_gain": mla_kr_gain, "mla_w_o": mla_w_o,
        "ffn_w_in": ffn_w_in, "ffn_conv_w": ffn_conv_w, "ffn_conv_b": ffn_conv_b,
        "ffn_w_out": ffn_w_out,
    }


def reference(x, positions, norm_mix_g, norm_ffn_g, pool_w, pool_scale,
              swa_w_qkv, swa_q_gain, swa_k_gain, swa_sinks, swa_w_o,
              mla_w_down, mla_q_a_gain, mla_kv_a_gain, mla_w_uq, mla_w_ukv,
              mla_qn_gain, mla_qr_gain, mla_kn_gain, mla_kr_gain, mla_w_o,
              ffn_w_in, ffn_conv_w, ffn_conv_b, ffn_w_out):
    for i in range(DEPTH):
        kind = i % N_MIXERS
        j = i // N_MIXERS
        h = rmsnorm(x, norm_mix_g[i])
        if kind == 0:
            y = pool_mixer(h, pool_w[j], pool_scale[j])
        elif kind == 1:
            y = swa_mixer(h, positions, swa_w_qkv[j], swa_q_gain[j], swa_k_gain[j],
                          swa_sinks[j], swa_w_o[j])
        else:
            y = mla_mixer(h, positions, mla_w_down[j], mla_q_a_gain[j], mla_kv_a_gain[j],
                          mla_w_uq[j], mla_w_ukv[j], mla_qn_gain[j], mla_qr_gain[j],
                          mla_kn_gain[j], mla_kr_gain[j], mla_w_o[j])
        x = x + y
        h = rmsnorm(x, norm_ffn_g[i])
        x = x + conv_glu(h, ffn_w_in[i], ffn_conv_w[i], ffn_conv_b[i], ffn_w_out[i])
    return x
```

```cpp
#include <hip/hip_runtime.h>
#include <hip/hip_cooperative_groups.h>
#include <cstdio>
namespace cg = cooperative_groups;

#ifndef MEGA_MODE
#define MEGA_MODE 1
#endif

#ifndef PHMASK
#define PHMASK 0xffffffffu
#endif
#define EN(k) ((PHMASK >> (k)) & 1u)
#ifndef REP_GEMM
#define REP_GEMM 1
#endif
#ifndef REP_ATTN
#define REP_ATTN 1
#endif
#ifndef REP_SYNC
#define REP_SYNC 1
#endif
#ifndef REP_MISC
#define REP_MISC 1
#endif
#define LAS __attribute__((address_space(3)))
#define DI __device__ __forceinline__
typedef unsigned short bf16_t;
typedef short bf16x8 __attribute__((ext_vector_type(8)));
typedef short s16x4 __attribute__((ext_vector_type(4)));
typedef float f32x2 __attribute__((ext_vector_type(2)));
typedef float f32x4 __attribute__((ext_vector_type(4)));
typedef float f32x16 __attribute__((ext_vector_type(16)));
typedef unsigned u32x2 __attribute__((ext_vector_type(2)));
typedef unsigned u32x4 __attribute__((ext_vector_type(4)));
typedef __bf16 hwbf16x2 __attribute__((ext_vector_type(2)));

constexpr int T = 16384, S = 4096, D = 2048, DFF = 5632;
constexpr float EPS = 1e-6f;
constexpr float LOG2E = 1.4426950408889634f;
constexpr int LDS_STAGE = 131072;
constexpr int LDS_BYTES = LDS_STAGE + 16;
constexpr int NPHASES = 34;

constexpr size_t OFF_WPOOL = 0;
constexpr size_t OFF_WQKV  = OFF_WPOOL + (size_t)2 * 4 * 512 * 512 * 2;
constexpr size_t OFF_WSWAO = OFF_WQKV + (size_t)2560 * 2048 * 2;
constexpr size_t OFF_WDOWN = OFF_WSWAO + (size_t)2048 * 2048 * 2;
constexpr size_t OFF_WUQ   = OFF_WDOWN + (size_t)1280 * 2048 * 2;
constexpr size_t OFF_WUKV  = OFF_WUQ + (size_t)3072 * 512 * 2;
constexpr size_t OFF_WMLAO = OFF_WUKV + (size_t)4096 * 512 * 2;
constexpr size_t OFF_WFIN  = OFF_WMLAO + (size_t)2048 * 2048 * 2;
constexpr size_t OFF_WFOUT = OFF_WFIN + (size_t)4 * 11264 * 2048 * 2;
constexpr size_t OFF_ROPE  = OFF_WFOUT + (size_t)4 * 2048 * 5632 * 2;
constexpr size_t OFF_RSTD  = OFF_ROPE + (size_t)S * 32 * 4 * 2;
constexpr size_t OFF_H     = OFF_RSTD + (size_t)T * 4;
constexpr size_t OFF_SCR   = OFF_H + (size_t)T * D * 2;
constexpr size_t OFF_U     = OFF_SCR;
constexpr size_t OFF_ACT   = OFF_U + (size_t)T * 11264 * 2;
constexpr size_t OFF_QKV32 = OFF_SCR;
constexpr size_t OFF_QS    = OFF_QKV32 + (size_t)T * 2560 * 4;
constexpr size_t OFF_KS    = OFF_QS + (size_t)T * 2048 * 2;
constexpr size_t OFF_VTS   = OFF_KS + (size_t)T * 256 * 2;
constexpr size_t OFF_D32   = OFF_SCR;
constexpr size_t OFF_CQ    = OFF_D32 + (size_t)T * 1280 * 4;
constexpr size_t OFF_CKV   = OFF_CQ + (size_t)T * 512 * 2;
constexpr size_t OFF_KPE   = OFF_CKV + (size_t)T * 512 * 2;
constexpr size_t OFF_Q32   = OFF_KPE + (size_t)T * 64 * 2;
constexpr size_t OFF_KV32  = OFF_Q32 + (size_t)T * 3072 * 4;
constexpr size_t OFF_QN    = OFF_KV32 + (size_t)T * 4096 * 4;
constexpr size_t OFF_KC    = OFF_QN + (size_t)T * 16 * 192 * 2;
constexpr size_t OFF_VT    = OFF_KC + (size_t)T * 16 * 192 * 2;
constexpr size_t OFF_BAR   = OFF_VT + (size_t)T * 2048 * 2;
constexpr size_t OFF_EP    = OFF_BAR + 16384;
constexpr size_t OFF_ER    = OFF_EP + (size_t)512 * DFF * 4;
constexpr size_t OFF_EV    = OFF_ER + (size_t)512 * DFF * 4;
constexpr size_t OFF_XB    = OFF_EV + (size_t)512 * DFF * 4;
constexpr size_t WS_END    = OFF_XB + (size_t)T * D * 2;

struct Job { const float* src; bf16_t* dst; int K, N, mode, pad; };
struct Params {
    const float* x_in; const int* positions; const float* norm_mix_g; const float* norm_ffn_g;
    const float* pool_scale; const float* swa_q_gain; const float* swa_k_gain; const float* swa_sinks;
    const float* mla_q_a_gain; const float* mla_kv_a_gain; const float* mla_qn_gain; const float* mla_qr_gain;
    const float* mla_kn_gain; const float* mla_kr_gain; const float* ffn_conv_w; const float* ffn_conv_b;
    float* out; unsigned char* ws;
    Job jobs[22]; int njobs; int pad;
};

DI unsigned char* wsp(const Params& p) { const unsigned long long a = (unsigned long long)p.ws; unsigned lo = __builtin_amdgcn_readfirstlane((unsigned)a), hi = __builtin_amdgcn_readfirstlane((unsigned)(a >> 32)); asm volatile("" : "+s"(lo), "+s"(hi)); return (unsigned char*)(((unsigned long long)hi << 32) | lo); }
#define WSP wsp(p)
DI unsigned pack2(float a, float b) { f32x2 v = {a, b}; hwbf16x2 r = __builtin_convertvector(v, hwbf16x2); return __builtin_bit_cast(unsigned, r); }
DI bf16_t f2bf(float a) { return (bf16_t)(pack2(a, 0.f) & 0xffffu); }
DI float bf2f(unsigned short b) { return __uint_as_float(((unsigned)b) << 16); }
DI float bflo(unsigned w) { return __uint_as_float(w << 16); }
DI float bfhi(unsigned w) { return __uint_as_float(w & 0xffff0000u); }
template <int CTRL> DI float dppf(float v) { return __builtin_bit_cast(float, __builtin_amdgcn_update_dpp(0, __builtin_bit_cast(int, v), CTRL, 0xf, 0xf, false)); }
DI float sum16(float v) { v += dppf<0x128>(v); v += dppf<0x124>(v); v += dppf<0x122>(v); v += dppf<0x121>(v); return v; }
DI f32x2 swap16(float v) { auto r = __builtin_amdgcn_permlane16_swap(__builtin_bit_cast(unsigned, v), __builtin_bit_cast(unsigned, v), false, false); return (f32x2){__builtin_bit_cast(float, r[0]), __builtin_bit_cast(float, r[1])}; }
DI f32x2 swap32(float v) { auto r = __builtin_amdgcn_permlane32_swap(__builtin_bit_cast(unsigned, v), __builtin_bit_cast(unsigned, v), false, false); return (f32x2){__builtin_bit_cast(float, r[0]), __builtin_bit_cast(float, r[1])}; }
DI float xsum32(float v) { return v + __shfl_xor(v, 32); }
DI float xmax32(float v) { return fmaxf(v, __shfl_xor(v, 32)); }
DI float wave_sum(float v) { for (int o = 32; o; o >>= 1) v += __shfl_xor(v, o); return v; }
DI float fast_exp2(float x) { return __builtin_amdgcn_exp2f(x); }
DI float dpp_ror1(float v)  { return __builtin_bit_cast(float, __builtin_amdgcn_update_dpp(0, __builtin_bit_cast(int, v), 0x121, 0xf, 0xf, false)); }
DI float dpp_ror15(float v) { return __builtin_bit_cast(float, __builtin_amdgcn_update_dpp(0, __builtin_bit_cast(int, v), 0x12F, 0xf, 0xf, false)); }
DI float silu_mul(float g, float v) { return g * v * __builtin_amdgcn_rcpf(1.0f + __builtin_amdgcn_exp2f(-LOG2E * g)); }
template <bool BF> DI f32x4 ldx4(const void* base, size_t e) {
    if constexpr (BF) { const u32x2 w = *(const u32x2*)((const bf16_t*)base + e); return (f32x4){__uint_as_float(w[0] << 16), __uint_as_float(w[0] & 0xffff0000u), __uint_as_float(w[1] << 16), __uint_as_float(w[1] & 0xffff0000u)}; }
    else return *(const f32x4*)((const float*)base + e);
}
DI int opaque_bid() { int b = blockIdx.x; asm volatile("" : "+s"(b)); return b; }
DI int opaque_tid() { int t = threadIdx.x; asm volatile("" : "+v"(t)); return t; }

DI void convert_phase(const Params& p, LAS unsigned char* lds) {
    unsigned char* const ws = wsp(p);
    const int bid = opaque_bid();
    LAS float* tile = (LAS float*)lds;
    const int tid = opaque_tid();
    for (int j = 0; j < p.njobs; ++j) {
        const float* src = p.jobs[j].src; bf16_t* dst = p.jobs[j].dst; const int K = p.jobs[j].K, N = p.jobs[j].N, mode = p.jobs[j].mode;
        const int nn = (N + 255) >> 8, ntile = (K >> 6) * nn;
        for (int ti = bid; ti < ntile; ti += gridDim.x) {
            const int tk = ti / nn, tn = ti - tk * nn;
            const int rr = tid >> 6, c4 = tid & 63, col = tn * 256 + c4 * 4;
            if (col < N) {
                f32x4 v[8];
#pragma unroll
                for (int i = 0; i < 8; ++i) v[i] = *(const f32x4*)(src + (size_t)(tk * 64 + rr + 8 * i) * N + col);
#pragma unroll
                for (int i = 0; i < 8; ++i) { LAS float* tp = tile + (rr + 8 * i) * 257 + c4 * 4; tp[0] = v[i][0]; tp[1] = v[i][1]; tp[2] = v[i][2]; tp[3] = v[i][3]; }
            }
            __syncthreads();
            const int k8 = (tid & 7) * 8;
#pragma unroll
            for (int r = 0; r < 4; ++r) {
                const int nl = (tid >> 3) + 64 * r, cbase = tn * 256 + 64 * r;
                if (cbase < N) {
                    u32x4 o;
#pragma unroll
                    for (int q = 0; q < 4; ++q) o[q] = pack2(tile[(k8 + 2 * q) * 257 + nl], tile[(k8 + 2 * q + 1) * 257 + nl]);
                    int orow = cbase;
                    if (mode) { const int hv = orow >= DFF, ch = orow - (hv ? DFF : 0); orow = (ch >> 7) * 256 + hv * 128 + (ch & 127); }
                    *(u32x4*)(dst + (size_t)(orow + (nl & 63)) * K + tk * 64 + k8) = o;
                }
            }
            __syncthreads();
        }
    }
    const int gtid = bid * 512 + tid, gsz = gridDim.x * 512;
    { u32x4* z = (u32x4*)(ws + OFF_WDOWN + (size_t)1088 * 2048 * 2); const int n16 = 192 * 2048 * 2 / 16;
      for (int i = gtid; i < n16; i += gsz) z[i] = (u32x4){0u, 0u, 0u, 0u}; }
    { float* ct = (float*)(ws + OFF_ROPE); float* st = ct + S * 32;
      for (int i = gtid; i < S * 32; i += gsz) { const int s = i >> 5, f = i & 31;
          const double inv = pow(10000.0, -(double)f / 32.0); const double a = (double)p.positions[s] * inv;
          ct[i] = (float)cos(a); st[i] = (float)sin(a); } }
}

template <bool BF> DI void rstd_phase(const Params& p, const void* x) {
    unsigned char* const ws = wsp(p);
    const int bid = opaque_bid();
    float* rstd = (float*)(ws + OFF_RSTD);
    const int tid = opaque_tid(), wid = tid >> 6, lane = tid & 63;
    for (int t = bid * 8 + wid; t < T; t += gridDim.x * 8) {
        float ss = 0.f;
#pragma unroll
        for (int i = 0; i < 8; ++i) { const f32x4 v = ldx4<BF>(x, (size_t)t * D + (i * 64 + lane) * 4); ss += v[0] * v[0] + v[1] * v[1] + v[2] * v[2] + v[3] * v[3]; }
        ss = wave_sum(ss);
        if (lane == 0) rstd[t] = rsqrtf(ss * (1.0f / D) + EPS);
    }
}

template <bool BF> DI void norm_phase(const Params& p, const void* x, const float* gain) {
    unsigned char* const ws = wsp(p);
    const int bid = opaque_bid();
    bf16_t* H = (bf16_t*)(ws + OFF_H);
    const int tid = opaque_tid(), wid = tid >> 6, lane = tid & 63;
    const int step = gridDim.x * 8;
    for (int t = bid * 8 + wid; t < T; t += 2 * step) {
        const int t2 = (t + step < T) ? t + step : t;
        f32x4 v[2][8];
#pragma unroll
        for (int q = 0; q < 2; ++q) {
            const int tt = q ? t2 : t;
#pragma unroll
            for (int i = 0; i < 4; ++i) {
                const size_t e = (size_t)tt * D + (i * 64 + lane) * 8;
                if constexpr (BF) { const u32x4 w = *(const u32x4*)((const bf16_t*)x + e);
                    v[q][2 * i] = (f32x4){bflo(w[0]), bfhi(w[0]), bflo(w[1]), bfhi(w[1])}; v[q][2 * i + 1] = (f32x4){bflo(w[2]), bfhi(w[2]), bflo(w[3]), bfhi(w[3])}; }
                else { v[q][2 * i] = *(const f32x4*)((const float*)x + e); v[q][2 * i + 1] = *(const f32x4*)((const float*)x + e + 4); }
            }
        }
        float ss[2] = {0.f, 0.f};
#pragma unroll
        for (int q = 0; q < 2; ++q)
#pragma unroll
            for (int i = 0; i < 8; ++i) ss[q] += v[q][i][0] * v[q][i][0] + v[q][i][1] * v[q][i][1] + v[q][i][2] * v[q][i][2] + v[q][i][3] * v[q][i][3];
        ss[0] = wave_sum(ss[0]); ss[1] = wave_sum(ss[1]);
#pragma unroll
        for (int q = 0; q < 2; ++q) {
            const int tt = q ? t2 : t;
            const float rs = rsqrtf(ss[q] * (1.0f / D) + EPS);
#pragma unroll
            for (int i = 0; i < 4; ++i) { const int c = (i * 64 + lane) * 8;
                const f32x4 g0 = *(const f32x4*)(gain + c), g1 = *(const f32x4*)(gain + c + 4);
                const f32x4 a = v[q][2 * i] * rs * g0, d = v[q][2 * i + 1] * rs * g1;
                u32x4 o; o[0] = pack2(a[0], a[1]); o[1] = pack2(a[2], a[3]); o[2] = pack2(d[0], d[1]); o[3] = pack2(d[2], d[3]);
                *(u32x4*)(H + (size_t)tt * D + c) = o; }
        }
    }
}

template <bool BF> DI void pool_phase(const Params& p, const void* x, const float* gain) {
    unsigned char* const ws = wsp(p);
    const int bid = opaque_bid();
    bf16_t* H = (bf16_t*)(ws + OFF_H); const float* rstd = (const float*)(ws + OFF_RSTD);
    const int tid = opaque_tid(), g = tid >> 7, left = 1 << g, right = (1 << g) - 1;
    const f32x4 gn = ((const f32x4*)gain)[tid];
    const int per = (T + gridDim.x - 1) / gridDim.x;
    if (gridDim.x == 256) {
        const int tb = bid * 64;
        f32x4 sm[4]; int pl[4], ph[4];
#pragma unroll
        for (int c = 0; c < 4; ++c) {
            const int t = tb + 16 * c, b = t / S, s = t - b * S;
            const int lo = max(s - left, 0), hi = min(s + right + 1, S);
            sm[c] = (f32x4){0.f, 0.f, 0.f, 0.f};
            for (int u = lo; u < hi; ++u) { const int tu = b * S + u; sm[c] += ldx4<BF>(x, (size_t)tu * D + tid * 4) * rstd[tu]; }
            pl[c] = lo; ph[c] = hi;
        }
        for (int i = 0; i < 16; ++i) {
            f32x4 va[4], vs[4], vm[4]; float ra[4], rs[4], rm[4], rc[4];
#pragma unroll
            for (int c = 0; c < 4; ++c) {
                const int t = tb + 16 * c + i, b = t / S, s = t - b * S;
                const int lo = max(s - left, 0), hi = min(s + right + 1, S);
                const int ta = b * S + hi - 1, ts = b * S + pl[c];
                va[c] = ldx4<BF>(x, (size_t)ta * D + tid * 4); vs[c] = ldx4<BF>(x, (size_t)ts * D + tid * 4); vm[c] = ldx4<BF>(x, (size_t)t * D + tid * 4);
                ra[c] = (i > 0 && hi > ph[c]) ? rstd[ta] : 0.f; rs[c] = (i > 0 && lo > pl[c]) ? rstd[ts] : 0.f; rm[c] = rstd[t];
                rc[c] = 1.0f / (float)(hi - lo); pl[c] = lo; ph[c] = hi;
            }
#pragma unroll
            for (int c = 0; c < 4; ++c) {
                const int t = tb + 16 * c + i;
                sm[c] += va[c] * ra[c] - vs[c] * rs[c];
                const f32x4 o = (sm[c] * rc[c] - vm[c] * rm[c]) * gn;
                u32x2 w; w[0] = pack2(o[0], o[1]); w[1] = pack2(o[2], o[3]);
                *(u32x2*)(H + (size_t)t * D + tid * 4) = w;
            }
        }
        return;
    }
    const int t0 = bid * per, t1 = min((bid + 1) * per, T);
    f32x4 sum = {0.f, 0.f, 0.f, 0.f}; int plo = 0, phi = 0;
    for (int t = t0; t < t1; ++t) {
        const int b = t / S, s = t - b * S;
        const int lo = max(s - left, 0), hi = min(s + right + 1, S);
        if (t == t0 || s == 0) {
            sum = (f32x4){0.f, 0.f, 0.f, 0.f};
            for (int u = lo; u < hi; ++u) { const int tu = b * S + u; const float r = rstd[tu]; const f32x4 v = ldx4<BF>(x, (size_t)tu * D + tid * 4); sum += v * r; }
        } else {
            if (hi > phi) { const int tu = b * S + hi - 1; sum += ldx4<BF>(x, (size_t)tu * D + tid * 4) * rstd[tu]; }
            if (lo > plo) { const int tu = b * S + plo;    sum -= ldx4<BF>(x, (size_t)tu * D + tid * 4) * rstd[tu]; }
        }
        plo = lo; phi = hi;
        const float rc = 1.0f / (float)(hi - lo);
        const f32x4 me = ldx4<BF>(x, (size_t)t * D + tid * 4) * rstd[t];
        const f32x4 o = (sum * rc - me) * gn;
        u32x2 w; w[0] = pack2(o[0], o[1]); w[1] = pack2(o[2], o[3]);
        *(u32x2*)(H + (size_t)t * D + tid * 4) = w;
    }
}

DI void glu_phase(const Params& p, int layer) {
    unsigned char* const ws = wsp(p);
    const int bid = opaque_bid();
    const bf16_t* U = (const bf16_t*)(ws + OFF_U); bf16_t* ACT = (bf16_t*)(ws + OFF_ACT);
    const float* cw = p.ffn_conv_w + (size_t)layer * 3 * DFF; const float* cb = p.ffn_conv_b + (size_t)layer * DFF;
    constexpr int NFG = DFF / 8, CH = 32, NTC = T / CH;
    const int tid = opaque_tid();
    for (int task = bid * 512 + tid; task < NFG * NTC; task += gridDim.x * 512) {
        const int tc = task / NFG, fg = task - tc * NFG, f0 = fg * 8, t0 = tc * CH;
        float w0[8], w1[8], w2[8], bb[8];
#pragma unroll
        for (int q = 0; q < 2; ++q) { const f32x4 a = *(const f32x4*)(cw + f0 + 4 * q), b = *(const f32x4*)(cw + DFF + f0 + 4 * q), c = *(const f32x4*)(cw + 2 * DFF + f0 + 4 * q), d = *(const f32x4*)(cb + f0 + 4 * q);
#pragma unroll
            for (int e = 0; e < 4; ++e) { w0[4 * q + e] = a[e]; w1[4 * q + e] = b[e]; w2[4 * q + e] = c[e]; bb[4 * q + e] = d[e]; } }
        const int s0 = t0 & (S - 1);
        u32x4 prev = {0u, 0u, 0u, 0u}, cur, nxt;
        if (s0 != 0) prev = *(const u32x4*)(U + (size_t)(t0 - 1) * 11264 + f0);
        cur = *(const u32x4*)(U + (size_t)t0 * 11264 + f0);
        for (int i = 0; i < CH; ++i) {
            const int t = t0 + i, s = s0 + i;
            nxt = (u32x4){0u, 0u, 0u, 0u};
            if (s != S - 1) nxt = *(const u32x4*)(U + (size_t)(t + 1) * 11264 + f0);
            const u32x4 vv = *(const u32x4*)(U + (size_t)t * 11264 + DFF + f0);
            u32x4 o;
#pragma unroll
            for (int q = 0; q < 4; ++q) {
                const float g0 = w0[2 * q] * bflo(prev[q]) + w1[2 * q] * bflo(cur[q]) + w2[2 * q] * bflo(nxt[q]) + bb[2 * q];
                const float g1 = w0[2 * q + 1] * bfhi(prev[q]) + w1[2 * q + 1] * bfhi(cur[q]) + w2[2 * q + 1] * bfhi(nxt[q]) + bb[2 * q + 1];
                const float a0 = g0 / (1.0f + __expf(-g0)) * bflo(vv[q]);
                const float a1 = g1 / (1.0f + __expf(-g1)) * bfhi(vv[q]);
                o[q] = pack2(a0, a1);
            }
            *(u32x4*)(ACT + (size_t)t * DFF + f0) = o;
            prev = cur; cur = nxt;
        }
    }
}

DI void glu_fix_phase(const Params& p, int layer) {
    unsigned char* const ws = wsp(p);
    const int bid = opaque_bid(), tid = opaque_tid();
    bf16_t* ACT = (bf16_t*)(ws + OFF_ACT);
    const float* EP = (const float*)(ws + OFF_EP); const float* ER = (const float*)(ws + OFF_ER); const float* EV = (const float*)(ws + OFF_EV);
    const float* cw = p.ffn_conv_w + (size_t)layer * 3 * DFF;
    constexpr int NC4 = DFF / 4;
    for (int task = bid * 512 + tid; task < 512 * NC4; task += gridDim.x * 512) {
        const int e = task / NC4, c = (task - e * NC4) * 4, b64 = e >> 1, last = e & 1, row = b64 * 64 + (last ? 63 : 0), sq = row & (S - 1);
        f32x4 gc = *(const f32x4*)(EP + (size_t)e * DFF + c);
        const f32x4 v = *(const f32x4*)(EV + (size_t)e * DFF + c);
        if (!last) { if (sq != 0) { const f32x4 nb = *(const f32x4*)(ER + (size_t)(e - 1) * DFF + c); gc += *(const f32x4*)(cw + c) * nb; } }
        else       { if (sq != S - 1) { const f32x4 nb = *(const f32x4*)(ER + (size_t)(e + 1) * DFF + c); gc += *(const f32x4*)(cw + 2 * DFF + c) * nb; } }
        u32x2 o;
        o[0] = pack2(gc[0] / (1.0f + __expf(-gc[0])) * v[0], gc[1] / (1.0f + __expf(-gc[1])) * v[1]);
        o[1] = pack2(gc[2] / (1.0f + __expf(-gc[2])) * v[2], gc[3] / (1.0f + __expf(-gc[3])) * v[3]);
        *(u32x2*)(ACT + (size_t)row * DFF + c) = o;
    }
}

DI void swa_prep_phase(const Params& p) {
    unsigned char* const ws = wsp(p);
    const int bid = opaque_bid();
    const bf16_t* QKV = (const bf16_t*)(ws + OFF_QKV32);
    bf16_t* QS = (bf16_t*)(ws + OFF_QS); bf16_t* KS = (bf16_t*)(ws + OFF_KS); bf16_t* VTS = (bf16_t*)(ws + OFF_VTS);
    const int tid = opaque_tid(), wid = tid >> 6, lane = tid & 63;
    const float qsc = 0.125f * LOG2E;
    for (int t = bid * 8 + wid; t < T; t += gridDim.x * 8) {
        const int b = t / S, s = t - b * S;
        const bf16_t* row = QKV + (size_t)t * 2560;
#pragma unroll
        for (int it = 0; it < 9; ++it) {
            const int col = it * 256 + lane * 4;
            const u32x2 wv = *(const u32x2*)(row + col); const f32x4 v = {bflo(wv[0]), bfhi(wv[0]), bflo(wv[1]), bfhi(wv[1])};
            float ss = v[0] * v[0] + v[1] * v[1] + v[2] * v[2] + v[3] * v[3];
            ss = sum16(ss);
            const float rs = rsqrtf(ss * (1.0f / 64.f) + EPS);
            const int d = col & 63;
            if (it < 8) { const f32x4 g = *(const f32x4*)(p.swa_q_gain + d); const float f = rs * qsc;
                u32x2 o; o[0] = pack2(v[0] * f * g[0], v[1] * f * g[1]); o[1] = pack2(v[2] * f * g[2], v[3] * f * g[3]);
                *(u32x2*)(QS + (size_t)t * 2048 + col) = o; }
            else { const f32x4 g = *(const f32x4*)(p.swa_k_gain + d); const int kvh = (col - 2048) >> 6;
                u32x2 o; o[0] = pack2(v[0] * rs * g[0], v[1] * rs * g[1]); o[1] = pack2(v[2] * rs * g[2], v[3] * rs * g[3]);
                *(u32x2*)(KS + ((size_t)(b * 4 + kvh) * S + s) * 64 + d) = o; }
        }
    }
    for (int ch = bid; ch < T / 64; ch += gridDim.x) {
        const int c = tid & 255, kvh = c >> 6, d = c & 63, tq = tid >> 8;
#pragma unroll
        for (int gi = 0; gi < 4; ++gi) {
            const int t0 = ch * 64 + (tq + 2 * gi) * 8, b = t0 / S, s0 = t0 - b * S;
            unsigned v[8];
#pragma unroll
            for (int e = 0; e < 8; ++e) v[e] = QKV[(size_t)(t0 + e) * 2560 + 2304 + c];
            u32x4 o; o[0] = v[0] | (v[1] << 16); o[1] = v[2] | (v[3] << 16); o[2] = v[4] | (v[5] << 16); o[3] = v[6] | (v[7] << 16);
            *(u32x4*)(VTS + ((size_t)(b * 4 + kvh) * 64 + d) * S + s0) = o;
        }
    }
}

template <int NDB, int VSTR>
DI void softmax_pv(const f32x16& sacc, float& m, float& l, f32x16 (&oacc)[NDB], LAS const unsigned char* vptr) {
    float mx = sacc[0];
#pragma unroll
    for (int i = 1; i < 16; ++i) mx = fmaxf(mx, sacc[i]);
    mx = xmax32(mx);
    if (__any(mx > m + 8.0f)) {
        const float mn = fmaxf(m, mx), alpha = fast_exp2(m - mn);
        l *= alpha; m = mn;
#pragma unroll
        for (int db = 0; db < NDB; ++db)
#pragma unroll
            for (int i = 0; i < 16; ++i) oacc[db][i] *= alpha;
    }
    float pv[16], ls = 0.f;
#pragma unroll
    for (int i = 0; i < 16; ++i) { pv[i] = fast_exp2(sacc[i] - m); ls += pv[i]; }
    l += ls;
#pragma unroll
    for (int s2 = 0; s2 < 2; ++s2) {
        u32x4 pw;
#pragma unroll
        for (int q = 0; q < 4; ++q) pw[q] = pack2(pv[8 * s2 + 2 * q], pv[8 * s2 + 2 * q + 1]);
        const bf16x8 pf = __builtin_bit_cast(bf16x8, pw);
#pragma unroll
        for (int db = 0; db < NDB; ++db) {
            const s16x4 lo = *(LAS const s16x4*)(vptr + db * 32 * VSTR + s2 * 32);
            const s16x4 hi = *(LAS const s16x4*)(vptr + db * 32 * VSTR + s2 * 32 + 16);
            const bf16x8 vf = __builtin_shufflevector(lo, hi, 0, 1, 2, 3, 4, 5, 6, 7);
            oacc[db] = __builtin_amdgcn_mfma_f32_32x32x16_bf16(vf, pf, oacc[db], 0, 0, 0);
        }
    }
}

template <int NDB, int VSTR>
DI void load_vfrags(bf16x8 (&vf)[2][NDB], LAS const unsigned char* vptr) {
#pragma unroll
    for (int s2 = 0; s2 < 2; ++s2)
#pragma unroll
        for (int db = 0; db < NDB; ++db) {
            const s16x4 lo = *(LAS const s16x4*)(vptr + db * 32 * VSTR + s2 * 32);
            const s16x4 hi = *(LAS const s16x4*)(vptr + db * 32 * VSTR + s2 * 32 + 16);
            vf[s2][db] = __builtin_shufflevector(lo, hi, 0, 1, 2, 3, 4, 5, 6, 7);
        }
}
template <int NDB>
DI void softmax_only(f32x16& sacc, float& m, float& l, f32x16 (&oacc)[NDB], bf16x8 (&pf)[2]) {
    float mx = sacc[0];
#pragma unroll
    for (int i = 1; i < 16; ++i) mx = fmaxf(mx, sacc[i]);
    mx = xmax32(mx);
    if (__any(mx > 8.0f)) {
        const float d = fmaxf(mx, 0.f), alpha = fast_exp2(-d);
        l *= alpha; m += d;
#pragma unroll
        for (int i = 0; i < 16; ++i) sacc[i] -= d;
#pragma unroll
        for (int db = 0; db < NDB; ++db)
#pragma unroll
            for (int i = 0; i < 16; ++i) oacc[db][i] *= alpha;
    }
    float pv[16], ls = 0.f;
#pragma unroll
    for (int i = 0; i < 16; ++i) { pv[i] = fast_exp2(sacc[i]); ls += pv[i]; }
    l += ls;
#pragma unroll
    for (int s2 = 0; s2 < 2; ++s2) {
        u32x4 pw;
#pragma unroll
        for (int q = 0; q < 4; ++q) pw[q] = pack2(pv[8 * s2 + 2 * q], pv[8 * s2 + 2 * q + 1]);
        pf[s2] = __builtin_bit_cast(bf16x8, pw);
    }
}

DI void swa_attn_phase(const Params& p, LAS unsigned char* lds) {
    unsigned char* const ws = wsp(p);
    const int bid = opaque_bid();
    constexpr int KSTR = 144, VSTR = 584, VOFF = 288 * KSTR;
    const bf16_t* QS = (const bf16_t*)(ws + OFF_QS); const bf16_t* KS = (const bf16_t*)(ws + OFF_KS); const bf16_t* VTS = (const bf16_t*)(ws + OFF_VTS);
    bf16_t* O = (bf16_t*)(ws + OFF_H);
    const int tid = opaque_tid(), wid = tid >> 6, lane = tid & 63, r = lane & 31, h = lane >> 5;
    for (int it0 = bid; it0 < 2048; it0 += gridDim.x) {
        const int item = (gridDim.x == 256) ? (((it0 >> 8) * 8 + (it0 & 7)) * 32 + ((it0 & 255) >> 3)) : it0;
        const int b = item >> 9, kvh = (item >> 7) & 3, qb = item & 127, q0 = qb * 32, kstart = q0 - 128;
        const bf16_t* Kg = KS + (size_t)(b * 4 + kvh) * S * 64; const bf16_t* Vg = VTS + (size_t)(b * 4 + kvh) * 64 * S;
        for (int c = tid; c < 2304; c += 512) { const int row = c >> 3, cc = c & 7, key = kstart + row;
            if (key >= 0 && key < S) *(LAS u32x4*)(lds + row * KSTR + cc * 16) = *(const u32x4*)(Kg + (size_t)key * 64 + cc * 8); }
        for (int c = tid; c < 2304; c += 512) { const int row = c / 36, cc = c - row * 36, key0 = kstart + cc * 8;
            if (key0 >= 0 && key0 < S) { const u32x4 v = *(const u32x4*)(Vg + (size_t)row * S + key0);
                LAS u32x2* dp = (LAS u32x2*)(lds + VOFF + row * VSTR + cc * 16); dp[0] = (u32x2){v[0], v[1]}; dp[1] = (u32x2){v[2], v[3]}; } }
        __syncthreads();
        const int hq = kvh * 8 + wid;
        const float slope2 = exp2f(-(float)(hq + 1) * 0.25f) * LOG2E, sink2 = p.swa_sinks[hq] * LOG2E;
        const bf16_t* Qp = QS + (size_t)(b * S + q0 + r) * 2048 + hq * 64 + 8 * h;
        bf16x8 qf[4];
#pragma unroll
        for (int ks = 0; ks < 4; ++ks) qf[ks] = *(const bf16x8*)(Qp + 16 * ks);
        const int qi = q0 + r, pq = p.positions[qi];
        float m = sink2, l = 0.f;
        f32x16 oacc[2];
#pragma unroll
        for (int db = 0; db < 2; ++db)
#pragma unroll
            for (int i = 0; i < 16; ++i) oacc[db][i] = 0.f;
        for (int blk = 0; blk < 9; ++blk) {
            const int k0 = kstart + blk * 32;
            if (k0 < 0 || k0 >= S) continue;
            f32x16 sacc;
#pragma unroll
            for (int i = 0; i < 16; ++i) sacc[i] = 0.f;
#pragma unroll
            for (int ks = 0; ks < 4; ++ks) { const bf16x8 a = *(LAS const bf16x8*)(lds + (blk * 32 + r) * KSTR + ks * 32 + h * 16);
                sacc = __builtin_amdgcn_mfma_f32_32x32x16_bf16(a, qf[ks], sacc, 0, 0, 0); }
#pragma unroll
            for (int i = 0; i < 16; ++i) { const int key = k0 + (i & 3) + 8 * (i >> 2) + 4 * h;
                const int dk = qi - key, dp = pq - p.positions[key];
                const float sv = sacc[i] - slope2 * (float)(dp < 0 ? -dp : dp);
                sacc[i] = ((dk < 0 ? -dk : dk) <= 128) ? sv : -INFINITY; }
            softmax_pv<2, VSTR>(sacc, m, l, oacc, lds + VOFF + r * VSTR + (blk * 32 + 4 * h) * 2);
        }
        const float lt = xsum32(l) + fast_exp2(sink2 - m), inv = 1.0f / lt;
        bf16_t* Op = O + (size_t)(b * S + qi) * 2048 + hq * 64 + 4 * h;
#pragma unroll
        for (int db = 0; db < 2; ++db)
#pragma unroll
            for (int g = 0; g < 4; ++g) { u32x2 o; o[0] = pack2(oacc[db][4 * g] * inv, oacc[db][4 * g + 1] * inv); o[1] = pack2(oacc[db][4 * g + 2] * inv, oacc[db][4 * g + 3] * inv);
                *(u32x2*)(Op + db * 32 + 8 * g) = o; }
        __syncthreads();
    }
}

DI void mla_prep1_phase(const Params& p) {
    unsigned char* const ws = wsp(p);
    const int bid = opaque_bid();
    const bf16_t* D32 = (const bf16_t*)(ws + OFF_D32);
    bf16_t* CQ = (bf16_t*)(ws + OFF_CQ); bf16_t* CKV = (bf16_t*)(ws + OFF_CKV); bf16_t* KPE = (bf16_t*)(ws + OFF_KPE);
    const float* ct = (const float*)(ws + OFF_ROPE); const float* st = ct + S * 32;
    const int tid = opaque_tid(), wid = tid >> 6, lane = tid & 63;
    for (int t = bid * 8 + wid; t < T; t += gridDim.x * 8) {
        const int s = t & (S - 1);
        const bf16_t* row = D32 + (size_t)t * 1280;
#pragma unroll
        for (int part = 0; part < 2; ++part) {
            const u32x2 wa = *(const u32x2*)(row + part * 512 + lane * 4), wc2 = *(const u32x2*)(row + part * 512 + 256 + lane * 4);
            const f32x4 a = {bflo(wa[0]), bfhi(wa[0]), bflo(wa[1]), bfhi(wa[1])}, c = {bflo(wc2[0]), bfhi(wc2[0]), bflo(wc2[1]), bfhi(wc2[1])};
            float ss = a[0] * a[0] + a[1] * a[1] + a[2] * a[2] + a[3] * a[3] + c[0] * c[0] + c[1] * c[1] + c[2] * c[2] + c[3] * c[3];
            ss = wave_sum(ss);
            const float rs = rsqrtf(ss * (1.0f / 512.f) + EPS);
            const float* gp = part ? p.mla_kv_a_gain : p.mla_q_a_gain; bf16_t* dst = (part ? CKV : CQ) + (size_t)t * 512;
            const f32x4 g0 = *(const f32x4*)(gp + lane * 4), g1 = *(const f32x4*)(gp + 256 + lane * 4);
            u32x2 o0, o1; o0[0] = pack2(a[0] * rs * g0[0], a[1] * rs * g0[1]); o0[1] = pack2(a[2] * rs * g0[2], a[3] * rs * g0[3]);
            o1[0] = pack2(c[0] * rs * g1[0], c[1] * rs * g1[1]); o1[1] = pack2(c[2] * rs * g1[2], c[3] * rs * g1[3]);
            *(u32x2*)(dst + lane * 4) = o0; *(u32x2*)(dst + 256 + lane * 4) = o1;
        }
        const float x = bf2f(row[1024 + lane]);
        const float ss = wave_sum(x * x);
        const float xn = x * rsqrtf(ss * (1.0f / 64.f) + EPS) * p.mla_kr_gain[lane];
        const float pr = __shfl_xor(xn, 32);
        const float cc = ct[s * 32 + (lane & 31)], sn = st[s * 32 + (lane & 31)];
        const float o = lane < 32 ? xn * cc - pr * sn : xn * cc + pr * sn;
        KPE[(size_t)t * 64 + lane] = f2bf(o);
    }
}

DI void mla_prep2_phase(const Params& p) {
    unsigned char* const ws = wsp(p);
    const int bid = opaque_bid();
    const bf16_t* Q32 = (const bf16_t*)(ws + OFF_Q32); const bf16_t* KV32 = (const bf16_t*)(ws + OFF_KV32); const bf16_t* KPE = (const bf16_t*)(ws + OFF_KPE);
    bf16_t* QN = (bf16_t*)(ws + OFF_QN); bf16_t* KC = (bf16_t*)(ws + OFF_KC); bf16_t* VT = (bf16_t*)(ws + OFF_VT);
    const float* ct = (const float*)(ws + OFF_ROPE); const float* st = ct + S * 32;
    const int tid = opaque_tid(), wid = tid >> 6, lane = tid & 63;
    const float qsc = 0.07216878364870322f * LOG2E;
    const int j = lane & 15, hsub = lane >> 4;
    float gqn[8], gkn[8], gqr[4];
#pragma unroll
    for (int e = 0; e < 8; ++e) { gqn[e] = p.mla_qn_gain[8 * j + e]; gkn[e] = p.mla_kn_gain[8 * j + e]; }
#pragma unroll
    for (int e = 0; e < 4; ++e) gqr[e] = p.mla_qr_gain[4 * j + e];
    const int tstride = gridDim.x * 8;
    for (int task0 = bid * 8 + wid; task0 < T * 4; task0 += 4 * tstride) {
        u32x4 wq4[4], wk4[4]; u32x2 wp4[4], kp4[4];
#pragma unroll
        for (int u = 0; u < 4; ++u) {
            const int task = task0 + u * tstride;
            if (task < T * 4) {
                const int t = task >> 2, hh = (task & 3) * 4 + hsub;
                const bf16_t* qrow = Q32 + (size_t)t * 3072 + hh * 192; const bf16_t* kvrow = KV32 + (size_t)t * 4096 + hh * 256;
                wq4[u] = *(const u32x4*)(qrow + 8 * j); wk4[u] = *(const u32x4*)(kvrow + 8 * j);
                wp4[u] = *(const u32x2*)(qrow + 128 + 4 * j); kp4[u] = *(const u32x2*)(KPE + (size_t)t * 64 + 4 * j);
            }
        }
#pragma unroll
        for (int u = 0; u < 4; ++u) {
            const int task = task0 + u * tstride;
            if (task < T * 4) {
                const int t = task >> 2, hh = (task & 3) * 4 + hsub, b = t / S, s = t - b * S;
                const size_t ob = ((size_t)(b * 16 + hh) * S + s) * 192;
                const u32x4 wq = wq4[u], wk = wk4[u]; const u32x2 wp = wp4[u], kp = kp4[u];
                float q[8], k[8], x[4];
#pragma unroll
                for (int e = 0; e < 4; ++e) { q[2 * e] = bflo(wq[e]); q[2 * e + 1] = bfhi(wq[e]); k[2 * e] = bflo(wk[e]); k[2 * e + 1] = bfhi(wk[e]); }
                x[0] = bflo(wp[0]); x[1] = bfhi(wp[0]); x[2] = bflo(wp[1]); x[3] = bfhi(wp[1]);
                float sq = 0.f, sk = 0.f, sx = 0.f;
#pragma unroll
                for (int e = 0; e < 8; ++e) { sq += q[e] * q[e]; sk += k[e] * k[e]; }
#pragma unroll
                for (int e = 0; e < 4; ++e) sx += x[e] * x[e];
                sq = sum16(sq); sk = sum16(sk); sx = sum16(sx);
                const float fq = rsqrtf(sq * (1.0f / 128.f) + EPS) * qsc, fk = rsqrtf(sk * (1.0f / 128.f) + EPS), fx = rsqrtf(sx * (1.0f / 64.f) + EPS);
                u32x4 oq, ok;
#pragma unroll
                for (int e = 0; e < 4; ++e) { oq[e] = pack2(q[2 * e] * fq * gqn[2 * e], q[2 * e + 1] * fq * gqn[2 * e + 1]); ok[e] = pack2(k[2 * e] * fk * gkn[2 * e], k[2 * e + 1] * fk * gkn[2 * e + 1]); }
                *(u32x4*)(QN + ob + 8 * j) = oq; *(u32x4*)(KC + ob + 8 * j) = ok;
                float ro[4];
#pragma unroll
                for (int e = 0; e < 4; ++e) { const float xn = x[e] * fx * gqr[e], pr = dppf<0x128>(xn);
                    const int fi = (4 * j + e) & 31; const float cc = ct[s * 32 + fi], sn = st[s * 32 + fi];
                    ro[e] = (j < 8 ? xn * cc - pr * sn : xn * cc + pr * sn) * qsc; }
                u32x2 op; op[0] = pack2(ro[0], ro[1]); op[1] = pack2(ro[2], ro[3]);
                *(u32x2*)(QN + ob + 128 + 4 * j) = op;
                *(u32x2*)(KC + ob + 128 + 4 * j) = kp;
            }
        }
    }
    for (int bt = bid; bt < (T / 64) * 16; bt += gridDim.x) {
        const int ch = bt >> 4, hh = bt & 15, dv = tid & 127, tq = tid >> 7;
#pragma unroll
        for (int gi = 0; gi < 2; ++gi) {
            const int t0 = ch * 64 + (tq + 4 * gi) * 8, b = t0 / S, s0 = t0 - b * S;
            unsigned v[8];
#pragma unroll
            for (int e = 0; e < 8; ++e) v[e] = KV32[(size_t)(t0 + e) * 4096 + hh * 256 + 128 + dv];
            u32x4 o; o[0] = v[0] | (v[1] << 16); o[1] = v[2] | (v[3] << 16); o[2] = v[4] | (v[5] << 16); o[3] = v[6] | (v[7] << 16);
            *(u32x4*)(VT + ((size_t)(b * 16 + hh) * 128 + dv) * S + s0) = o;
        }
    }
}

DI void mla_attn_phase(const Params& p, LAS unsigned char* lds) {
    unsigned char* const ws = wsp(p);
    const int bid = opaque_bid();
    constexpr int KSTR = 400, VSTR = 136, KBUF = 64 * KSTR, VBUF = 128 * VSTR, BUF = KBUF + VBUF, NT = S / 64;
    const bf16_t* QN = (const bf16_t*)(ws + OFF_QN); const bf16_t* KC = (const bf16_t*)(ws + OFF_KC); const bf16_t* VT = (const bf16_t*)(ws + OFF_VT);
    bf16_t* O = (bf16_t*)(ws + OFF_H);
    const int tid = opaque_tid(), wid = tid >> 6, lane = tid & 63, r = lane & 31, h = lane >> 5;
    unsigned klds[3], vlds[2], vgo[2];
#pragma unroll
    for (int i = 0; i < 3; ++i) { const int c = tid + 512 * i, kr = c / 24; klds[i] = (unsigned)(kr * KSTR + (c - kr * 24) * 16); }
#pragma unroll
    for (int i = 0; i < 2; ++i) { const int c = tid + 512 * i, vr = c >> 3, vc = c & 7; vlds[i] = (unsigned)(KBUF + vr * VSTR + vc * 16); vgo[i] = (unsigned)((vr * S + vc * 8) * 2); }
    const unsigned kgo = (unsigned)tid * 16u;
    for (int it0 = bid; it0 < 1024; it0 += gridDim.x) {
        const int item = (gridDim.x == 256) ? (((it0 >> 8) * 8 + (it0 & 7)) * 32 + ((it0 & 255) >> 3)) : it0;
        const int bh = item >> 4, qb = item & 15, b = bh >> 4, hh = bh & 15, q0 = qb * 256 + wid * 32;
        const char* Kg = (const char*)(KC + (size_t)bh * S * 192); const char* Vg = (const char*)(VT + (size_t)bh * 128 * S);
        const bf16_t* Qp = QN + ((size_t)bh * S + q0 + r) * 192 + 8 * h;
        bf16x8 qf[12];
#pragma unroll
        for (int ks = 0; ks < 12; ++ks) qf[ks] = *(const bf16x8*)(Qp + 16 * ks);
        u32x4 kreg[3], vreg[2];
#define MLA_LOAD(k0) do { const char* kt_ = Kg + (size_t)(k0) * 384; const char* vt_ = Vg + (size_t)(k0) * 2; \
                          _Pragma("unroll") for (int i = 0; i < 3; ++i) kreg[i] = *(const u32x4*)(kt_ + kgo + i * 8192); \
                          _Pragma("unroll") for (int i = 0; i < 2; ++i) vreg[i] = *(const u32x4*)(vt_ + vgo[i]); } while (0)
#define MLA_STORE(bufp) do { _Pragma("unroll") for (int i = 0; i < 3; ++i) *(LAS u32x4*)((bufp) + klds[i]) = kreg[i]; \
                             _Pragma("unroll") for (int i = 0; i < 2; ++i) { LAS u32x2* dp = (LAS u32x2*)((bufp) + vlds[i]); \
                                 dp[0] = (u32x2){vreg[i][0], vreg[i][1]}; dp[1] = (u32x2){vreg[i][2], vreg[i][3]}; } } while (0)
        MLA_LOAD(0); MLA_STORE(lds);
        __syncthreads();
        float m = 0.f, l = 0.f;
        f32x16 oacc[4];
#pragma unroll
        for (int db = 0; db < 4; ++db)
#pragma unroll
            for (int i = 0; i < 16; ++i) oacc[db][i] = 0.f;
        for (int t = 0; t < NT; ++t) {
            if (t + 1 < NT) MLA_LOAD((t + 1) * 64);
            LAS unsigned char* kb = lds + (t & 1) * BUF;
#pragma unroll
            for (int blk = 0; blk < 2; ++blk) {
                bf16x8 kf[12];
                LAS const unsigned char* kp = kb + (blk * 32 + r) * KSTR + h * 16;
#pragma unroll
                for (int ks = 0; ks < 4; ++ks) kf[ks] = *(LAS const bf16x8*)(kp + ks * 32);
                f32x16 sacc;
#pragma unroll
                for (int i = 0; i < 16; ++i) sacc[i] = -m;
#pragma unroll
                for (int kg = 0; kg < 3; ++kg) {
                    if (kg < 2) {
#pragma unroll
                        for (int ks = 0; ks < 4; ++ks) kf[4 * (kg + 1) + ks] = *(LAS const bf16x8*)(kp + (4 * (kg + 1) + ks) * 32);
                    }
#pragma unroll
                    for (int ks = 0; ks < 4; ++ks) sacc = __builtin_amdgcn_mfma_f32_32x32x16_bf16(kf[4 * kg + ks], qf[4 * kg + ks], sacc, 0, 0, 0);
                }
                bf16x8 vf[2][4], pf[2];
                load_vfrags<4, VSTR>(vf, kb + KBUF + r * VSTR + (blk * 32 + 4 * h) * 2);
                softmax_only<4>(sacc, m, l, oacc, pf);
#pragma unroll
                for (int s2 = 0; s2 < 2; ++s2)
#pragma unroll
                    for (int db = 0; db < 4; ++db) oacc[db] = __builtin_amdgcn_mfma_f32_32x32x16_bf16(vf[s2][db], pf[s2], oacc[db], 0, 0, 0);
            }
            if (t + 1 < NT) MLA_STORE(lds + ((t + 1) & 1) * BUF);
            __syncthreads();
        }
#undef MLA_LOAD
#undef MLA_STORE
        const float lt = xsum32(l), inv = 1.0f / lt;
        bf16_t* Op = O + (size_t)(b * S + q0 + r) * 2048 + hh * 128 + 4 * h;
#pragma unroll
        for (int db = 0; db < 4; ++db)
#pragma unroll
            for (int g = 0; g < 4; ++g) { u32x2 o; o[0] = pack2(oacc[db][4 * g] * inv, oacc[db][4 * g + 1] * inv); o[1] = pack2(oacc[db][4 * g + 2] * inv, oacc[db][4 * g + 3] * inv);
                *(u32x2*)(Op + db * 32 + 8 * g) = o; }
    }
}

constexpr int BM = 256, BK = 64, HALF = 128, HTB = HALF * BK * 2, NXCD = 8, WGM = 8;
DI int lds_byte(int r, int c) { const int st = (r >> 4) * 2 + (c >> 5), rr = r & 15, cc = c & 31, ob = rr * 64 + cc * 2; return st * 1024 + (ob ^ (((ob >> 9) & 1) << 5)); }
DI int perm32(int rho) { const int n = rho >> 4, i = rho & 15; return 8 * (i >> 2) + 4 * n + (i & 3); }
DI void stage_rc(int b, int& R, int& C) { const int st = b / 1024, sb = b % 1024, swz = sb ^ (((sb >> 9) & 1) << 5); R = (st >> 1) * 16 + swz / 64; C = (st & 1) * 32 + (swz % 64) / 2; }
struct Unit { int pm, pn; };
DI bool sched_next(int i, int nM, int nN, int G, int c, Unit& u) {
    const int nwg = nM * nN; const long L = (long)i * G + c; if (L >= nwg) return false;
    int wgid = (int)L; { const int q = nwg / NXCD, r = nwg % NXCD, xcd = wgid % NXCD, off = wgid / NXCD; wgid = (xcd < r ? xcd * (q + 1) : r * (q + 1) + (xcd - r) * q) + off; }
    const int nig = WGM * nN, gid = wgid / nig, fm = gid * WGM, gsz = (nM - fm) < WGM ? (nM - fm) : WGM;
    u.pm = fm + ((wgid % nig) % gsz); u.pn = (wgid % nig) / gsz; return true;
}

struct EpiF32 {
    static constexpr bool PERM = false;
    float* C; int ldc; float* C2; int ldc2; int split;
    DI void operator()(const f32x4 (&acc)[2][2][4][2], const Unit& u, int wr, int wc, int fr, int fq) const {
        float* base = C; int ld = ldc, pn = u.pn; if (pn >= split) { base = C2; ld = ldc2; pn -= split; }
        const int row0 = u.pm * BM + wr * 64 + fr, col0 = pn * BM + wc * 32 + 4 * fq;
#pragma unroll
        for (int ai = 0; ai < 2; ++ai)
#pragma unroll
            for (int m = 0; m < 4; ++m) { float* rowp = base + (size_t)(row0 + ai * HALF + m * 16) * ld + col0;
#pragma unroll
                for (int bj = 0; bj < 2; ++bj)
#pragma unroll
                    for (int n = 0; n < 2; ++n) *(f32x4*)(rowp + bj * HALF + n * 16) = acc[ai][bj][m][n]; }
    }
};
struct EpiBf16 {
    static constexpr bool PERM = true;
    bf16_t* O1; int ldc1; bf16_t* O2; int ldc2; int split;
    DI void operator()(const f32x4 (&acc)[2][2][4][2], const Unit& u, int wr, int wc, int fr, int fq) const {
        bf16_t* O = O1; int ldc = ldc1, pn = u.pn; if (pn >= split) { O = O2; ldc = ldc2; pn -= split; }
        const int row0 = u.pm * BM + wr * 64 + fr, col0 = pn * BM + wc * 32 + 8 * fq;
#pragma unroll
        for (int ai = 0; ai < 2; ++ai)
#pragma unroll
            for (int m = 0; m < 4; ++m) { bf16_t* rowp = O + (size_t)(row0 + ai * HALF + m * 16) * ldc + col0;
#pragma unroll
                for (int bj = 0; bj < 2; ++bj) { const f32x4 v0 = acc[ai][bj][m][0], v1 = acc[ai][bj][m][1];
                    u32x4 o; o[0] = pack2(v0[0], v0[1]); o[1] = pack2(v0[2], v0[3]); o[2] = pack2(v1[0], v1[1]); o[3] = pack2(v1[2], v1[3]);
                    *(u32x4*)(rowp + bj * HALF) = o; } }
    }
};
template <bool IB, bool OB> struct EpiRes {
    static constexpr bool PERM = true;
    const void* Xin; void* Xout; const float* scale;
    DI void operator()(const f32x4 (&acc)[2][2][4][2], const Unit& u, int wr, int wc, int fr, int fq) const {
        const int row0 = u.pm * BM + wr * 64 + fr, col0 = u.pn * BM + wc * 32 + 8 * fq;
        f32x4 sc[2][2];
#pragma unroll
        for (int bj = 0; bj < 2; ++bj)
#pragma unroll
            for (int n = 0; n < 2; ++n) sc[bj][n] = scale ? *(const f32x4*)(scale + col0 + bj * HALF + 4 * n) : (f32x4){1.f, 1.f, 1.f, 1.f};
#pragma unroll
        for (int ai = 0; ai < 2; ++ai)
#pragma unroll
            for (int m = 0; m < 4; ++m) { const size_t ro = (size_t)(row0 + ai * HALF + m * 16) * D + col0;
#pragma unroll
                for (int bj = 0; bj < 2; ++bj) {
                    f32x4 x0, x1;
                    if constexpr (IB) { const u32x4 w = *(const u32x4*)((const bf16_t*)Xin + ro + bj * HALF);
                        x0 = (f32x4){bflo(w[0]), bfhi(w[0]), bflo(w[1]), bfhi(w[1])}; x1 = (f32x4){bflo(w[2]), bfhi(w[2]), bflo(w[3]), bfhi(w[3])}; }
                    else { x0 = *(const f32x4*)((const float*)Xin + ro + bj * HALF); x1 = *(const f32x4*)((const float*)Xin + ro + bj * HALF + 4); }
                    x0 += acc[ai][bj][m][0] * sc[bj][0]; x1 += acc[ai][bj][m][1] * sc[bj][1];
                    if constexpr (OB) { u32x4 o; o[0] = pack2(x0[0], x0[1]); o[1] = pack2(x0[2], x0[3]); o[2] = pack2(x1[0], x1[1]); o[3] = pack2(x1[2], x1[3]);
                        *(u32x4*)((bf16_t*)Xout + ro + bj * HALF) = o; }
                    else { *(f32x4*)((float*)Xout + ro + bj * HALF) = x0; *(f32x4*)((float*)Xout + ro + bj * HALF + 4) = x1; } } }
    }
};
struct EpiGlu {
    static constexpr bool PERM = true;
    const float* cw; const float* cb; bf16_t* ACT; float* EP; float* ER; float* EV;
    DI void operator()(const f32x4 (&acc)[2][2][4][2], const Unit& u, int wr, int wc, int fr, int fq) const {
        const int row0 = u.pm * BM + wr * 64 + fr, ch0 = u.pn * 128 + wc * 32 + 8 * fq;
        f32x4 w0[2], w1[2], w2[2], bb[2];
#pragma unroll
        for (int n = 0; n < 2; ++n) { w0[n] = *(const f32x4*)(cw + ch0 + 4 * n); w1[n] = *(const f32x4*)(cw + DFF + ch0 + 4 * n); w2[n] = *(const f32x4*)(cw + 2 * DFF + ch0 + 4 * n); bb[n] = *(const f32x4*)(cb + ch0 + 4 * n); }
#pragma unroll
        for (int ai = 0; ai < 2; ++ai)
#pragma unroll
            for (int m = 0; m < 4; ++m) {
                const bool efirst = (m == 0) && (fr == 0), elast = (m == 3) && (fr == 15);
                const int row = row0 + ai * HALF + m * 16;
                f32x4 gc[2];
#pragma unroll
                for (int n = 0; n < 2; ++n) {
                    const f32x4 g = acc[ai][0][m][n];
                    const f32x4 gprev = acc[ai][0][m > 0 ? m - 1 : 0][n], gnext = acc[ai][0][m < 3 ? m + 1 : 3][n];
                    f32x4 up, dn;
#pragma unroll
                    for (int e = 0; e < 4; ++e) {
                        const float pu = (m > 0 && fr == 15) ? gprev[e] : g[e];
                        const float pd = (m < 3 && fr == 0) ? gnext[e] : g[e];
                        up[e] = dpp_ror1(pu); dn[e] = dpp_ror15(pd);
                    }
                    if (efirst) up = (f32x4){0.f, 0.f, 0.f, 0.f};
                    if (elast) dn = (f32x4){0.f, 0.f, 0.f, 0.f};
                    gc[n] = w0[n] * up + w1[n] * g + w2[n] * dn + bb[n];
                }
                if (efirst || elast) {
                    const size_t eo = (size_t)((row >> 6) * 2 + (elast ? 1 : 0)) * DFF + ch0;
#pragma unroll
                    for (int n = 0; n < 2; ++n) { *(f32x4*)(EP + eo + 4 * n) = gc[n]; *(f32x4*)(ER + eo + 4 * n) = acc[ai][0][m][n]; *(f32x4*)(EV + eo + 4 * n) = acc[ai][1][m][n]; }
                } else {
                    const f32x4 v0 = acc[ai][1][m][0], v1 = acc[ai][1][m][1];
                    u32x4 o;
                    o[0] = pack2(silu_mul(gc[0][0], v0[0]), silu_mul(gc[0][1], v0[1])); o[1] = pack2(silu_mul(gc[0][2], v0[2]), silu_mul(gc[0][3], v0[3]));
                    o[2] = pack2(silu_mul(gc[1][0], v1[0]), silu_mul(gc[1][1], v1[1])); o[3] = pack2(silu_mul(gc[1][2], v1[2]), silu_mul(gc[1][3], v1[3]));
                    *(u32x4*)(ACT + (size_t)row * DFF + ch0) = o;
                }
            }
    }
};
struct MapPlain { const bf16_t* A; const bf16_t* B; int lda, ldb;
    DI const char* a(const Unit& u) const { return (const char*)(A + (size_t)u.pm * BM * lda); }
    DI const char* b(const Unit& u) const { return (const char*)(B + (size_t)u.pn * BM * ldb); } };
struct MapPool { const bf16_t* A; const bf16_t* B;
    DI const char* a(const Unit& u) const { return (const char*)(A + (size_t)u.pm * BM * 2048 + (u.pn >> 1) * 512); }
    DI const char* b(const Unit& u) const { return (const char*)(B + ((size_t)(u.pn >> 1) * 512 + (u.pn & 1) * 256) * 512); } };
struct MapUqkv { const bf16_t* A1; const bf16_t* A2; const bf16_t* B1; const bf16_t* B2;
    DI const char* a(const Unit& u) const { return (const char*)((u.pn < 12 ? A1 : A2) + (size_t)u.pm * BM * 512); }
    DI const char* b(const Unit& u) const { return (const char*)(u.pn < 12 ? B1 + (size_t)u.pn * BM * 512 : B2 + (size_t)(u.pn - 12) * BM * 512); } };

template <class Map, class Epi>
DI void gemm_phase(LAS unsigned char* lds, const Map& MP, const Epi& E, const int nM, const int nN, const int K, const int lda, const int ldb) {
    const int tid = opaque_tid(), wid = __builtin_amdgcn_readfirstlane(tid >> 6), lane = tid & 63, wr = wid >> 2, wc = wid & 3, fr = lane & 15, fq = lane >> 4;
    const int nt = K / BK, G = gridDim.x, cblk = opaque_bid();
    unsigned voffA[2], voffB[2];
#pragma unroll
    for (int i = 0; i < 2; ++i) { int R, C; stage_rc(tid * 16 + i * 8192, R, C); const int Rb = Epi::PERM ? ((R & ~31) + perm32(R & 31)) : R;
        voffA[i] = (unsigned)(R * lda + C) * 2u; voffB[i] = (unsigned)(Rb * ldb + C) * 2u; }
    const size_t kstep = (size_t)(BK * 2);
    const size_t hstepA = (size_t)HALF * lda * 2, hstepB = (size_t)HALF * ldb * 2;
    const unsigned ldsw = (unsigned)wid * 1024u;
    const int aoff = lds_byte(wr * 64 + fr, fq * 8), boff = lds_byte(wc * 32 + fr, fq * 8);
#define PG8_SA(b, h) (((b) * 2 + (h)) * HTB)
#define PG8_SB(b, h) ((4 + (b) * 2 + (h)) * HTB)
#define PG8_STAGE(bufoff, gbase, voff) do { _Pragma("unroll") for (int _i = 0; _i < 2; ++_i) \
        __builtin_amdgcn_global_load_lds((const unsigned*)((const char*)(gbase) + (voff)[_i]), (LAS unsigned*)(lds + (bufoff) + ldsw + _i * 8192), 16, 0, 0); } while (0)
#define PG8_LDA(dst, b, h) do { _Pragma("unroll") for (int m = 0; m < 4; ++m) _Pragma("unroll") for (int k = 0; k < 2; ++k) dst[m][k] = *(const LAS bf16x8*)(lds + PG8_SA(b, h) + aoff + m * 2048 + k * 1024); } while (0)
#define PG8_LDB(dst, b, h) do { _Pragma("unroll") for (int n = 0; n < 2; ++n) _Pragma("unroll") for (int k = 0; k < 2; ++k) dst[n][k] = *(const LAS bf16x8*)(lds + PG8_SB(b, h) + boff + n * 2048 + k * 1024); } while (0)
#define PG8_MMA(ai, bj, At, Bt) do { __builtin_amdgcn_s_setprio(1); _Pragma("unroll") for (int m = 0; m < 4; ++m) _Pragma("unroll") for (int n = 0; n < 2; ++n) _Pragma("unroll") for (int k = 0; k < 2; ++k) \
        acc[ai][bj][m][n] = __builtin_amdgcn_mfma_f32_16x16x32_bf16(Bt[n][k], At[m][k], acc[ai][bj][m][n], 0, 0, 0); __builtin_amdgcn_s_setprio(0); } while (0)
#define PG8_WAIT_V(n) asm volatile("s_waitcnt vmcnt(" #n ")" ::: "memory")
#define PG8_WAIT_L(n) asm volatile("s_waitcnt lgkmcnt(" #n ")" ::: "memory")
#define PG8_BAR __builtin_amdgcn_s_barrier()
#define PG8_SCHED __builtin_amdgcn_sched_barrier(0)
    Unit cur, nxt; int ui = 0;
    if (!sched_next(0, nM, nN, G, cblk, cur)) return;
    f32x4 acc[2][2][4][2];
#pragma unroll
    for (int a = 0; a < 2; ++a)
#pragma unroll
        for (int b = 0; b < 2; ++b)
#pragma unroll
            for (int m = 0; m < 4; ++m)
#pragma unroll
                for (int n = 0; n < 2; ++n) acc[a][b][m][n] = (f32x4){0.f, 0.f, 0.f, 0.f};
    bf16x8 At[4][2], B0[2][2], B1[2][2];
    const char* cA = MP.a(cur); const char* cB = MP.b(cur);
    PG8_STAGE(PG8_SB(0, 0), cB, voffB); PG8_STAGE(PG8_SA(0, 0), cA, voffA); PG8_STAGE(PG8_SB(0, 1), cB + hstepB, voffB); PG8_STAGE(PG8_SA(0, 1), cA + hstepA, voffA);
    if (wr == 1) PG8_BAR;
    PG8_WAIT_V(4); PG8_BAR;
    PG8_STAGE(PG8_SB(1, 0), cB + kstep, voffB); PG8_STAGE(PG8_SA(1, 0), cA + kstep, voffA); PG8_STAGE(PG8_SB(1, 1), cB + hstepB + kstep, voffB);
    PG8_WAIT_V(6); PG8_BAR;
    for (;;) {
        const bool has_next = sched_next(ui + 1, nM, nN, G, cblk, nxt);
        const char* nA = has_next ? MP.a(nxt) : cA; const char* nB = has_next ? MP.b(nxt) : cB;
        for (int t = 0; t < nt; t += 2) {
            const bool last = (t == nt - 2);
            const char* a1 = cA + (size_t)(t + 1) * kstep;
            const char* a2 = last ? nA : cA + (size_t)(t + 2) * kstep; const char* b2 = last ? nB : cB + (size_t)(t + 2) * kstep;
            const char* a3 = a2 + kstep; const char* b3 = b2 + kstep;
            PG8_LDB(B0, 0, 0); PG8_SCHED; PG8_LDA(At, 0, 0); PG8_STAGE(PG8_SA(1, 1), a1 + hstepA, voffA);
            PG8_WAIT_L(8); PG8_BAR; PG8_WAIT_L(0); PG8_MMA(0, 0, At, B0); PG8_BAR; PG8_SCHED;
            PG8_LDB(B1, 0, 1); PG8_STAGE(PG8_SB(0, 0), b2, voffB);
            PG8_BAR; PG8_WAIT_L(0); PG8_MMA(0, 1, At, B1); PG8_BAR;
            PG8_LDA(At, 0, 1); PG8_STAGE(PG8_SA(0, 0), a2, voffA);
            PG8_BAR; PG8_WAIT_L(0); PG8_MMA(1, 0, At, B0); PG8_BAR; PG8_SCHED;
            PG8_STAGE(PG8_SB(0, 1), b2 + hstepB, voffB);
            PG8_WAIT_V(6); PG8_BAR; PG8_MMA(1, 1, At, B1); PG8_BAR;
            PG8_LDB(B0, 1, 0); PG8_SCHED; PG8_LDA(At, 1, 0); PG8_STAGE(PG8_SA(0, 1), a2 + hstepA, voffA);
            PG8_WAIT_L(8); PG8_BAR; PG8_WAIT_L(0); PG8_MMA(0, 0, At, B0); PG8_BAR; PG8_SCHED;
            PG8_LDB(B1, 1, 1); PG8_STAGE(PG8_SB(1, 0), b3, voffB);
            PG8_BAR; PG8_WAIT_L(0); PG8_MMA(0, 1, At, B1); PG8_BAR;
            PG8_LDA(At, 1, 1); PG8_STAGE(PG8_SA(1, 0), a3, voffA);
            PG8_BAR; PG8_WAIT_L(0); PG8_MMA(1, 0, At, B0); PG8_BAR; PG8_SCHED;
            PG8_STAGE(PG8_SB(1, 1), b3 + hstepB, voffB);
            PG8_WAIT_V(6); PG8_BAR; PG8_MMA(1, 1, At, B1); PG8_BAR;
        }
        { int frr = fr, fqq = fq; asm volatile("" : "+v"(frr), "+v"(fqq)); E(acc, cur, wr, wc, frr, fqq); }
        if (!has_next) break;
#pragma unroll
        for (int a = 0; a < 2; ++a)
#pragma unroll
            for (int b = 0; b < 2; ++b)
#pragma unroll
                for (int m = 0; m < 4; ++m)
#pragma unroll
                    for (int n = 0; n < 2; ++n) acc[a][b][m][n] = (f32x4){0.f, 0.f, 0.f, 0.f};
        cur = nxt; cA = nA; cB = nB; ++ui;
    }
    PG8_WAIT_V(0);
    if (wr == 0) PG8_BAR;
    PG8_BAR;
#undef PG8_SA
#undef PG8_SB
#undef PG8_STAGE
#undef PG8_LDA
#undef PG8_LDB
#undef PG8_MMA
#undef PG8_WAIT_V
#undef PG8_WAIT_L
#undef PG8_BAR
#undef PG8_SCHED
}


#define XB_TMO      128
#define XB_XCNT(j)  (256  + 64 * (j))
#define XB_XSUB(j)  (1280 + 64 * (j))
#define XB_XGEN(j)  (2304 + 64 * (j))
#define XB_TOP      3328
#define XB_TOPGEN   3392
#define XCD_BAR_WORDS 3456
#define XB_SPIN_CAP (1u << 18)
DI unsigned xb_ld(unsigned* p)              { return __hip_atomic_load(p, __ATOMIC_RELAXED, __HIP_MEMORY_SCOPE_AGENT); }
DI unsigned xb_add(unsigned* p, unsigned v) { return __hip_atomic_fetch_add(p, v, __ATOMIC_RELAXED, __HIP_MEMORY_SCOPE_AGENT); }
DI unsigned xb_xcc_id() { return (unsigned)__builtin_amdgcn_s_getreg((3 << 11) | 20) & 0xFu; }
#define XB_SPIN(cond, bar) do { unsigned _sp = 0; while (cond) { __builtin_amdgcn_s_sleep(1); \
    if ((++_sp & 255u) == 0u) { if (xb_ld(&(bar)[XB_TMO])) break; if (_sp > XB_SPIN_CAP) { atomicAdd(&(bar)[XB_TMO], 1u); break; } } } } while (0)
struct XcdBarrier { unsigned* bar; unsigned x; volatile LAS unsigned* st; };
DI XcdBarrier xcd_barrier_post(unsigned* bar, volatile LAS unsigned* st) {
    XcdBarrier b; b.bar = bar; b.x = xb_xcc_id(); b.st = st;
    if (threadIdx.x == 0) (void)xb_add(&bar[XB_XCNT(b.x)], 1u);
    return b;
}
DI void xcd_barrier_complete(unsigned* bar, unsigned x, unsigned& nloc, unsigned& nx) {
    const unsigned G = gridDim.x * gridDim.y * gridDim.z;
    unsigned sum, cnt, mine, sp = 0u;
    for (;;) {
        sum = 0u; cnt = 0u; mine = 0u;
#pragma unroll
        for (unsigned j = 0; j < 16; ++j) { const unsigned c = xb_ld(&bar[XB_XCNT(j)]); sum += c; cnt += (c > 0u) ? 1u : 0u; mine = (j == x) ? c : mine; }
        if (sum == G) break;
        __builtin_amdgcn_s_sleep(1);
        if ((++sp & 255u) == 0u) { if (xb_ld(&bar[XB_TMO])) break; if (sp > XB_SPIN_CAP) { atomicAdd(&bar[XB_TMO], 1u); break; } }
    }
    nloc = mine > 0u ? mine : 1u; nx = cnt > 0u ? cnt : 1u;
}
DI void xcd_barrier(const XcdBarrier& b) {
    asm volatile("s_waitcnt vmcnt(0)" ::: "memory");
    __syncthreads();
    if (threadIdx.x == 0) {
        unsigned* bar = b.bar;
        __builtin_amdgcn_s_waitcnt(0);
        unsigned nloc = b.st[0], nx = b.st[1];
        if (nloc == 0u) { xcd_barrier_complete(bar, b.x, nloc, nx); b.st[0] = nloc; b.st[1] = nx; }
        const unsigned old = xb_add(&bar[XB_XSUB(b.x)], 1u);
        const unsigned gen = old / nloc;
        if (old + 1u == (gen + 1u) * nloc) {
            __builtin_amdgcn_fence(__ATOMIC_RELEASE, "agent");
            asm volatile("s_waitcnt vmcnt(0)" ::: "memory");
            const unsigned og = xb_add(&bar[XB_TOP], 1u);
            const unsigned tg = og / nx;
            if (og + 1u == (tg + 1u) * nx) xb_add(&bar[XB_TOPGEN], 1u);
            else XB_SPIN(xb_ld(&bar[XB_TOPGEN]) == tg, bar);
            __builtin_amdgcn_fence(__ATOMIC_ACQUIRE, "agent");
            xb_add(&bar[XB_XGEN(b.x)], 1u);
            asm volatile("s_waitcnt vmcnt(0)" ::: "memory");
        } else {
            XB_SPIN(xb_ld(&bar[XB_XGEN(b.x)]) == gen, bar);
            __builtin_amdgcn_fence(__ATOMIC_ACQUIRE, "agent");
            asm volatile("s_waitcnt vmcnt(0)" ::: "memory");
        }
    }
    __syncthreads();
}

#define PH(...) do { if (MEGA || phase == idx) { unsigned char* const wsl = wsp(p); (void)wsl; __VA_ARGS__; } if (MEGA) { for (int _s = 0; _s < REP_SYNC; ++_s) { if (p.njobs < 0) grid.sync(); xcd_barrier(xb); } } ++idx; } while (0)
#define PHR(REP, ...) _Pragma("unroll 1") for (int rep = 0; rep < (REP); ++rep) { float* const xo = (rep == (REP) - 1) ? p.out : (float*)(p.ws + OFF_QN); (void)xo; PH(__VA_ARGS__); }
template <bool MEGA, int layer>
DI void run_layer(const Params& p, LAS unsigned char* lds, int& idx, const int phase, const XcdBarrier& xb, cg::grid_group& grid) {
    constexpr int kind = layer % 3, j = layer / 3;
        const float* gmix = p.norm_mix_g + layer * D;
    unsigned char* const wsl0 = wsp(p); (void)wsl0;
        if constexpr (kind == 0) {
            const void* xin = layer == 0 ? (const void*)p.x_in : (const void*)(wsl0 + OFF_XB);
            if constexpr (layer != 0) { PHR(REP_MISC, if (EN(1)) rstd_phase<true>(p, xin)); }
            PHR(REP_MISC, if (EN(2)) pool_phase<layer != 0>(p, xin, gmix));
            PHR(REP_GEMM, if (EN(3)) { MapPool mp{(const bf16_t*)(wsl + OFF_H), (const bf16_t*)(wsl + OFF_WPOOL) + (size_t)j * 4 * 512 * 512}; EpiRes<layer != 0, true> ep{xin, wsl + OFF_XB, p.pool_scale + j * D};
                 gemm_phase(lds, mp, ep, 64, 8, 512, 2048, 512); });
        } else if constexpr (kind == 1) {
            PHR(REP_MISC, if (EN(4)) norm_phase<true>(p, wsl + OFF_XB, gmix));
            PHR(REP_GEMM, if (EN(5)) { MapPlain mp{(const bf16_t*)(wsl + OFF_H), (const bf16_t*)(wsl + OFF_WQKV), 2048, 2048}; EpiBf16 ep{(bf16_t*)(wsl + OFF_QKV32), 2560, nullptr, 0, 1 << 30};
                 gemm_phase(lds, mp, ep, 64, 10, 2048, 2048, 2048); });
            PHR(REP_MISC, if (EN(6)) swa_prep_phase(p));
            PHR(REP_ATTN, if (EN(7)) swa_attn_phase(p, lds));
            PHR(REP_GEMM, if (EN(8)) { MapPlain mp{(const bf16_t*)(wsl + OFF_H), (const bf16_t*)(wsl + OFF_WSWAO), 2048, 2048}; EpiRes<true, true> ep{wsl + OFF_XB, wsl + OFF_XB, nullptr};
                 gemm_phase(lds, mp, ep, 64, 8, 2048, 2048, 2048); });
        } else {
            PHR(REP_MISC, if (EN(9)) norm_phase<true>(p, wsl + OFF_XB, gmix));
            PHR(REP_GEMM, if (EN(10)) { MapPlain mp{(const bf16_t*)(wsl + OFF_H), (const bf16_t*)(wsl + OFF_WDOWN), 2048, 2048}; EpiBf16 ep{(bf16_t*)(wsl + OFF_D32), 1280, nullptr, 0, 1 << 30};
                 gemm_phase(lds, mp, ep, 64, 5, 2048, 2048, 2048); });
            PHR(REP_MISC, if (EN(11)) mla_prep1_phase(p));
            PHR(REP_GEMM, if (EN(12)) { MapUqkv mp{(const bf16_t*)(wsl + OFF_CQ), (const bf16_t*)(wsl + OFF_CKV), (const bf16_t*)(wsl + OFF_WUQ), (const bf16_t*)(wsl + OFF_WUKV)};
                 EpiBf16 ep{(bf16_t*)(wsl + OFF_Q32), 3072, (bf16_t*)(wsl + OFF_KV32), 4096, 12};
                 gemm_phase(lds, mp, ep, 64, 28, 512, 512, 512); });
            PHR(REP_MISC, if (EN(13)) mla_prep2_phase(p));
            PHR(REP_ATTN, if (EN(14)) mla_attn_phase(p, lds));
            PHR(REP_GEMM, if (EN(15)) { MapPlain mp{(const bf16_t*)(wsl + OFF_H), (const bf16_t*)(wsl + OFF_WMLAO), 2048, 2048}; EpiRes<true, true> ep{wsl + OFF_XB, wsl + OFF_XB, nullptr};
                 gemm_phase(lds, mp, ep, 64, 8, 2048, 2048, 2048); });
        }
        PHR(REP_MISC, if (EN(16)) norm_phase<true>(p, wsl + OFF_XB, p.norm_ffn_g + layer * D));
        PHR(REP_GEMM, if (EN(17)) { MapPlain mp{(const bf16_t*)(wsl + OFF_H), (const bf16_t*)(wsl + OFF_WFIN) + (size_t)layer * 11264 * 2048, 2048, 2048};
             EpiGlu ep{p.ffn_conv_w + (size_t)layer * 3 * DFF, p.ffn_conv_b + (size_t)layer * DFF, (bf16_t*)(wsl + OFF_ACT), (float*)(wsl + OFF_EP), (float*)(wsl + OFF_ER), (float*)(wsl + OFF_EV)};
             gemm_phase(lds, mp, ep, 64, 44, 2048, 2048, 2048); });
        PHR(REP_MISC, if (EN(18)) glu_fix_phase(p, layer));
        PHR(REP_GEMM, if (EN(19)) { MapPlain mp{(const bf16_t*)(wsl + OFF_ACT), (const bf16_t*)(wsl + OFF_WFOUT) + (size_t)layer * 2048 * 5632, 5632, 5632}; EpiRes<true, layer != 3> ep{wsl + OFF_XB, layer == 3 ? (void*)p.out : (void*)(wsl + OFF_XB), nullptr};
             gemm_phase(lds, mp, ep, 64, 8, 5632, 5632, 5632); });
}

template <bool MEGA>
__global__ void __launch_bounds__(512) fwd_kernel(Params p, int phase) {
    extern __shared__ __attribute__((aligned(16))) unsigned char lds_raw[];
    LAS unsigned char* lds = (LAS unsigned char*)lds_raw;
    cg::grid_group grid = cg::this_grid();
    int idx = 0;
    volatile LAS unsigned* xst = (volatile LAS unsigned*)(lds + LDS_STAGE);
    if (threadIdx.x == 0) { xst[0] = 0u; xst[1] = 0u; xst[2] = 0u; xst[3] = 0u; }
    __syncthreads();
    const XcdBarrier xb = xcd_barrier_post((unsigned*)(p.ws + OFF_BAR), xst);
    PHR(REP_MISC, if (EN(0)) convert_phase(p, lds); rstd_phase<false>(p, p.x_in));
    run_layer<MEGA, 0>(p, lds, idx, phase, xb, grid);
    run_layer<MEGA, 1>(p, lds, idx, phase, xb, grid);
    run_layer<MEGA, 2>(p, lds, idx, phase, xb, grid);
    run_layer<MEGA, 3>(p, lds, idx, phase, xb, grid);
#undef PH
#undef PHR
}

__global__ void nan_fill(float* out, int n) { for (int i = blockIdx.x * blockDim.x + threadIdx.x; i < n; i += gridDim.x * blockDim.x) out[i] = __uint_as_float(0x7fc00000u); }

extern "C" void kernel_launch(void* const* d_in, const int* in_sizes, int n_in, void* d_out, int out_size, void* d_ws, size_t ws_size, hipStream_t stream) {
    if (ws_size < WS_END || n_in < 25) { fprintf(stderr, "kernel_launch: workspace too small (%zu < %zu) or bad n_in %d\n", ws_size, (size_t)WS_END, n_in);
        nan_fill<<<256, 256, 0, stream>>>((float*)d_out, out_size); return; }
    Params p{};
    p.x_in = (const float*)d_in[0]; p.positions = (const int*)d_in[1]; p.norm_mix_g = (const float*)d_in[2]; p.norm_ffn_g = (const float*)d_in[3];
    p.pool_scale = (const float*)d_in[5]; p.swa_q_gain = (const float*)d_in[7]; p.swa_k_gain = (const float*)d_in[8]; p.swa_sinks = (const float*)d_in[9];
    p.mla_q_a_gain = (const float*)d_in[12]; p.mla_kv_a_gain = (const float*)d_in[13]; p.mla_qn_gain = (const float*)d_in[16]; p.mla_qr_gain = (const float*)d_in[17];
    p.mla_kn_gain = (const float*)d_in[18]; p.mla_kr_gain = (const float*)d_in[19]; p.ffn_conv_w = (const float*)d_in[22]; p.ffn_conv_b = (const float*)d_in[23];
    p.out = (float*)d_out; p.ws = (unsigned char*)d_ws;
    unsigned char* ws = (unsigned char*)d_ws; int nj = 0;
    auto add = [&](const float* src, size_t off, int K, int N, int mode = 0) { p.jobs[nj].src = src; p.jobs[nj].dst = (bf16_t*)(ws + off); p.jobs[nj].K = K; p.jobs[nj].N = N; p.jobs[nj].mode = mode; ++nj; };
    for (int g = 0; g < 8; ++g) add((const float*)d_in[4] + (size_t)g * 512 * 512, OFF_WPOOL + (size_t)g * 512 * 512 * 2, 512, 512);
    add((const float*)d_in[6], OFF_WQKV, 2048, 2560);
    add((const float*)d_in[10], OFF_WSWAO, 2048, 2048);
    add((const float*)d_in[11], OFF_WDOWN, 2048, 1088);
    add((const float*)d_in[14], OFF_WUQ, 512, 3072);
    add((const float*)d_in[15], OFF_WUKV, 512, 4096);
    add((const float*)d_in[20], OFF_WMLAO, 2048, 2048);
    for (int i = 0; i < 4; ++i) add((const float*)d_in[21] + (size_t)i * 2048 * 11264, OFF_WFIN + (size_t)i * 11264 * 2048 * 2, 2048, 11264, 1);
    for (int i = 0; i < 4; ++i) add((const float*)d_in[24] + (size_t)i * 5632 * 2048, OFF_WFOUT + (size_t)i * 2048 * 5632 * 2, 5632, 2048);
    p.njobs = nj;
    static int grid_blocks = 0;
    if (!grid_blocks) {
        int dev = 0, cus = 0, per_cu = 0;
        (void)hipGetDevice(&dev); (void)hipDeviceGetAttribute(&cus, hipDeviceAttributeMultiprocessorCount, dev);
        (void)hipFuncSetAttribute((const void*)fwd_kernel<MEGA_MODE != 0>, hipFuncAttributeMaxDynamicSharedMemorySize, LDS_BYTES);
        (void)hipOccupancyMaxActiveBlocksPerMultiprocessor(&per_cu, (const void*)fwd_kernel<MEGA_MODE != 0>, 512, LDS_BYTES);
        if (per_cu < 1) per_cu = 1;
        if (per_cu > 1) per_cu = 1;
        if (cus < 1) cus = 256;
        grid_blocks = cus * per_cu; (void)hipGetLastError();
    }
    (void)hipMemsetAsync((unsigned char*)d_ws + OFF_BAR, 0, 16384, stream);
#if MEGA_MODE
    int ph = -1; void* args[] = {&p, &ph};
    hipError_t e = hipLaunchCooperativeKernel((const void*)fwd_kernel<true>, dim3(grid_blocks), dim3(512), args, LDS_BYTES, stream);
    if (e != hipSuccess) fprintf(stderr, "cooperative launch failed: %s (grid %d)\n", hipGetErrorString(e), grid_blocks);
#else
    for (int ph = 0; ph < NPHASES; ++ph) hipLaunchKernelGGL(fwd_kernel<false>, dim3(grid_blocks), dim3(512), LDS_BYTES, stream, p, ph);
#endif
}
```

```cpp
#include <hip/hip_runtime.h>
#include <hip/hip_cooperative_groups.h>
#include <cstdio>
namespace cg = cooperative_groups;

#ifndef MEGA_MODE
#define MEGA_MODE 1
#endif

#ifndef PHMASK
#define PHMASK 0xffffffffu
#endif
#define EN(k) ((PHMASK >> (k)) & 1u)
#ifndef REP_GEMM
#define REP_GEMM 1
#endif
#ifndef REP_ATTN
#define REP_ATTN 1
#endif
#ifndef REP_SYNC
#define REP_SYNC 1
#endif
#ifndef REP_MISC
#define REP_MISC 1
#endif
#define LAS __attribute__((address_space(3)))
#define DI __device__ __forceinline__
typedef unsigned short bf16_t;
typedef short bf16x8 __attribute__((ext_vector_type(8)));
typedef short s16x4 __attribute__((ext_vector_type(4)));
typedef float f32x2 __attribute__((ext_vector_type(2)));
typedef float f32x4 __attribute__((ext_vector_type(4)));
typedef float f32x16 __attribute__((ext_vector_type(16)));
typedef unsigned u32x2 __attribute__((ext_vector_type(2)));
typedef unsigned u32x4 __attribute__((ext_vector_type(4)));
typedef __bf16 hwbf16x2 __attribute__((ext_vector_type(2)));

constexpr int T = 16384, S = 4096, D = 2048, DFF = 5632;
constexpr float EPS = 1e-6f;
constexpr float LOG2E = 1.4426950408889634f;
constexpr int LDS_STAGE = 131072;
constexpr int LDS_BYTES = LDS_STAGE + 16;
constexpr int NPHASES = 34;

constexpr size_t OFF_WPOOL = 0;
constexpr size_t OFF_WQKV  = OFF_WPOOL + (size_t)2 * 4 * 512 * 512 * 2;
constexpr size_t OFF_WSWAO = OFF_WQKV + (size_t)2560 * 2048 * 2;
constexpr size_t OFF_WDOWN = OFF_WSWAO + (size_t)2048 * 2048 * 2;
constexpr size_t OFF_WUQ   = OFF_WDOWN + (size_t)1280 * 2048 * 2;
constexpr size_t OFF_WUKV  = OFF_WUQ + (size_t)3072 * 512 * 2;
constexpr size_t OFF_WMLAO = OFF_WUKV + (size_t)4096 * 512 * 2;
constexpr size_t OFF_WFIN  = OFF_WMLAO + (size_t)2048 * 2048 * 2;
constexpr size_t OFF_WFOUT = OFF_WFIN + (size_t)4 * 11264 * 2048 * 2;
constexpr size_t OFF_ROPE  = OFF_WFOUT + (size_t)4 * 2048 * 5632 * 2;
constexpr size_t OFF_RSTD  = OFF_ROPE + (size_t)S * 32 * 4 * 2;
constexpr size_t OFF_H     = OFF_RSTD + (size_t)T * 4;
constexpr size_t OFF_SCR   = OFF_H + (size_t)T * D * 2;
constexpr size_t OFF_U     = OFF_SCR;
constexpr size_t OFF_ACT   = OFF_U + (size_t)T * 11264 * 2;
constexpr size_t OFF_QKV32 = OFF_SCR;
constexpr size_t OFF_QS    = OFF_QKV32 + (size_t)T * 2560 * 4;
constexpr size_t OFF_KS    = OFF_QS + (size_t)T * 2048 * 2;
constexpr size_t OFF_VTS   = OFF_KS + (size_t)T * 256 * 2;
constexpr size_t OFF_D32   = OFF_SCR;
constexpr size_t OFF_CQ    = OFF_D32 + (size_t)T * 1280 * 4;
constexpr size_t OFF_CKV   = OFF_CQ + (size_t)T * 512 * 2;
constexpr size_t OFF_KPE   = OFF_CKV + (size_t)T * 512 * 2;
constexpr size_t OFF_Q32   = OFF_KPE + (size_t)T * 64 * 2;
constexpr size_t OFF_KV32  = OFF_Q32 + (size_t)T * 3072 * 4;
constexpr size_t OFF_QN    = OFF_KV32 + (size_t)T * 4096 * 4;
constexpr size_t OFF_KC    = OFF_QN + (size_t)T * 16 * 192 * 2;
constexpr size_t OFF_VT    = OFF_KC + (size_t)T * 16 * 192 * 2;
constexpr size_t OFF_BAR   = OFF_VT + (size_t)T * 2048 * 2;
constexpr size_t OFF_EP    = OFF_BAR + 16384;
constexpr size_t OFF_ER    = OFF_EP + (size_t)512 * DFF * 4;
constexpr size_t OFF_EV    = OFF_ER + (size_t)512 * DFF * 4;
constexpr size_t OFF_XB    = OFF_EV + (size_t)512 * DFF * 4;
constexpr size_t WS_END    = OFF_XB + (size_t)T * D * 2;

struct Job { const float* src; bf16_t* dst; int K, N, mode, pad; };
struct Params {
    const float* x_in; const int* positions; const float* norm_mix_g; const float* norm_ffn_g;
    const float* pool_scale; const float* swa_q_gain; const float* swa_k_gain; const float* swa_sinks;
    const float* mla_q_a_gain; const float* mla_kv_a_gain; const float* mla_qn_gain; const float* mla_qr_gain;
    const float* mla_kn_gain; const float* mla_kr_gain; const float* ffn_conv_w; const float* ffn_conv_b;
    float* out; unsigned char* ws;
    Job jobs[22]; int njobs; int pad;
};

DI unsigned char* wsp(const Params& p) { const unsigned long long a = (unsigned long long)p.ws; unsigned lo = __builtin_amdgcn_readfirstlane((unsigned)a), hi = __builtin_amdgcn_readfirstlane((unsigned)(a >> 32)); asm volatile("" : "+s"(lo), "+s"(hi)); return (unsigned char*)(((unsigned long long)hi << 32) | lo); }
#define WSP wsp(p)
DI unsigned pack2(float a, float b) { f32x2 v = {a, b}; hwbf16x2 r = __builtin_convertvector(v, hwbf16x2); return __builtin_bit_cast(unsigned, r); }
DI bf16_t f2bf(float a) { return (bf16_t)(pack2(a, 0.f) & 0xffffu); }
DI float bf2f(unsigned short b) { return __uint_as_float(((unsigned)b) << 16); }
DI float bflo(unsigned w) { return __uint_as_float(w << 16); }
DI float bfhi(unsigned w) { return __uint_as_float(w & 0xffff0000u); }
template <int CTRL> DI float dppf(float v) { return __builtin_bit_cast(float, __builtin_amdgcn_update_dpp(0, __builtin_bit_cast(int, v), CTRL, 0xf, 0xf, false)); }
DI float sum16(float v) { v += dppf<0x128>(v); v += dppf<0x124>(v); v += dppf<0x122>(v); v += dppf<0x121>(v); return v; }
DI f32x2 swap16(float v) { auto r = __builtin_amdgcn_permlane16_swap(__builtin_bit_cast(unsigned, v), __builtin_bit_cast(unsigned, v), false, false); return (f32x2){__builtin_bit_cast(float, r[0]), __builtin_bit_cast(float, r[1])}; }
DI f32x2 swap32(float v) { auto r = __builtin_amdgcn_permlane32_swap(__builtin_bit_cast(unsigned, v), __builtin_bit_cast(unsigned, v), false, false); return (f32x2){__builtin_bit_cast(float, r[0]), __builtin_bit_cast(float, r[1])}; }
DI float xsum32(float v) { return v + __shfl_xor(v, 32); }
DI float xmax32(float v) { return fmaxf(v, __shfl_xor(v, 32)); }
DI float wave_sum(float v) { for (int o = 32; o; o >>= 1) v += __shfl_xor(v, o); return v; }
DI float fast_exp2(float x) { return __builtin_amdgcn_exp2f(x); }
DI float dpp_ror1(float v)  { return __builtin_bit_cast(float, __builtin_amdgcn_update_dpp(0, __builtin_bit_cast(int, v), 0x121, 0xf, 0xf, false)); }
DI float dpp_ror15(float v) { return __builtin_bit_cast(float, __builtin_amdgcn_update_dpp(0, __builtin_bit_cast(int, v), 0x12F, 0xf, 0xf, false)); }
DI float silu_mul(float g, float v) { return g * v * __builtin_amdgcn_rcpf(1.0f + __builtin_amdgcn_exp2f(-LOG2E * g)); }
template <bool BF> DI f32x4 ldx4(const void* base, size_t e) {
    if constexpr (BF) { const u32x2 w = *(const u32x2*)((const bf16_t*)base + e); return (f32x4){__uint_as_float(w[0] << 16), __uint_as_float(w[0] & 0xffff0000u), __uint_as_float(w[1] << 16), __uint_as_float(w[1] & 0xffff0000u)}; }
    else return *(const f32x4*)((const float*)base + e);
}
DI int opaque_bid() { int b = blockIdx.x; asm volatile("" : "+s"(b)); return b; }
DI int opaque_tid() { int t = threadIdx.x; asm volatile("" : "+v"(t)); return t; }

DI void convert_phase(const Params& p, LAS unsigned char* lds) {
    unsigned char* const ws = wsp(p);
    const int bid = opaque_bid();
    LAS float* tile = (LAS float*)lds;
    const int tid = opaque_tid();
    for (int j = 0; j < p.njobs; ++j) {
        const float* src = p.jobs[j].src; bf16_t* dst = p.jobs[j].dst; const int K = p.jobs[j].K, N = p.jobs[j].N, mode = p.jobs[j].mode;
        const int nn = (N + 255) >> 8, ntile = (K >> 6) * nn;
        for (int ti = bid; ti < ntile; ti += gridDim.x) {
            const int tk = ti / nn, tn = ti - tk * nn;
            const int rr = tid >> 6, c4 = tid & 63, col = tn * 256 + c4 * 4;
            if (col < N) {
                f32x4 v[8];
#pragma unroll
                for (int i = 0; i < 8; ++i) v[i] = *(const f32x4*)(src + (size_t)(tk * 64 + rr + 8 * i) * N + col);
#pragma unroll
                for (int i = 0; i < 8; ++i) { LAS float* tp = tile + (rr + 8 * i) * 257 + c4 * 4; tp[0] = v[i][0]; tp[1] = v[i][1]; tp[2] = v[i][2]; tp[3] = v[i][3]; }
            }
            __syncthreads();
            const int k8 = (tid & 7) * 8;
#pragma unroll
            for (int r = 0; r < 4; ++r) {
                const int nl = (tid >> 3) + 64 * r, cbase = tn * 256 + 64 * r;
                if (cbase < N) {
                    u32x4 o;
#pragma unroll
                    for (int q = 0; q < 4; ++q) o[q] = pack2(tile[(k8 + 2 * q) * 257 + nl], tile[(k8 + 2 * q + 1) * 257 + nl]);
                    int orow = cbase;
                    if (mode) { const int hv = orow >= DFF, ch = orow - (hv ? DFF : 0); orow = (ch >> 7) * 256 + hv * 128 + (ch & 127); }
                    *(u32x4*)(dst + (size_t)(orow + (nl & 63)) * K + tk * 64 + k8) = o;
                }
            }
            __syncthreads();
        }
    }
    const int gtid = bid * 512 + tid, gsz = gridDim.x * 512;
    { u32x4* z = (u32x4*)(ws + OFF_WDOWN + (size_t)1088 * 2048 * 2); const int n16 = 192 * 2048 * 2 / 16;
      for (int i = gtid; i < n16; i += gsz) z[i] = (u32x4){0u, 0u, 0u, 0u}; }
    { float* ct = (float*)(ws + OFF_ROPE); float* st = ct + S * 32;
      for (int i = gtid; i < S * 32; i += gsz) { const int s = i >> 5, f = i & 31;
          const double inv = pow(10000.0, -(double)f / 32.0); const double a = (double)p.positions[s] * inv;
          ct[i] = (float)cos(a); st[i] = (float)sin(a); } }
}

template <bool BF> DI void rstd_phase(const Params& p, const void* x) {
    unsigned char* const ws = wsp(p);
    const int bid = opaque_bid();
    float* rstd = (float*)(ws + OFF_RSTD);
    const int tid = opaque_tid(), wid = tid >> 6, lane = tid & 63;
    for (int t = bid * 8 + wid; t < T; t += gridDim.x * 8) {
        float ss = 0.f;
#pragma unroll
        for (int i = 0; i < 8; ++i) { const f32x4 v = ldx4<BF>(x, (size_t)t * D + (i * 64 + lane) * 4); ss += v[0] * v[0] + v[1] * v[1] + v[2] * v[2] + v[3] * v[3]; }
        ss = wave_sum(ss);
        if (lane == 0) rstd[t] = rsqrtf(ss * (1.0f / D) + EPS);
    }
}

template <bool BF> DI void norm_phase(const Params& p, const void* x, const float* gain) {
    unsigned char* const ws = wsp(p);
    const int bid = opaque_bid();
    bf16_t* H = (bf16_t*)(ws + OFF_H);
    const int tid = opaque_tid(), wid = tid >> 6, lane = tid & 63;
    const int step = gridDim.x * 8;
    for (int t = bid * 8 + wid; t < T; t += 2 * step) {
        const int t2 = (t + step < T) ? t + step : t;
        f32x4 v[2][8];
#pragma unroll
        for (int q = 0; q < 2; ++q) {
            const int tt = q ? t2 : t;
#pragma unroll
            for (int i = 0; i < 4; ++i) {
                const size_t e = (size_t)tt * D + (i * 64 + lane) * 8;
                if constexpr (BF) { const u32x4 w = *(const u32x4*)((const bf16_t*)x + e);
                    v[q][2 * i] = (f32x4){bflo(w[0]), bfhi(w[0]), bflo(w[1]), bfhi(w[1])}; v[q][2 * i + 1] = (f32x4){bflo(w[2]), bfhi(w[2]), bflo(w[3]), bfhi(w[3])}; }
                else { v[q][2 * i] = *(const f32x4*)((const float*)x + e); v[q][2 * i + 1] = *(const f32x4*)((const float*)x + e + 4); }
            }
        }
        float ss[2] = {0.f, 0.f};
#pragma unroll
        for (int q = 0; q < 2; ++q)
#pragma unroll
            for (int i = 0; i < 8; ++i) ss[q] += v[q][i][0] * v[q][i][0] + v[q][i][1] * v[q][i][1] + v[q][i][2] * v[q][i][2] + v[q][i][3] * v[q][i][3];
        ss[0] = wave_sum(ss[0]); ss[1] = wave_sum(ss[1]);
#pragma unroll
        for (int q = 0; q < 2; ++q) {
            const int tt = q ? t2 : t;
            const float rs = rsqrtf(ss[q] * (1.0f / D) + EPS);
#pragma unroll
            for (int i = 0; i < 4; ++i) { const int c = (i * 64 + lane) * 8;
                const f32x4 g0 = *(const f32x4*)(gain + c), g1 = *(const f32x4*)(gain + c + 4);
                const f32x4 a = v[q][2 * i] * rs * g0, d = v[q][2 * i + 1] * rs * g1;
                u32x4 o; o[0] = pack2(a[0], a[1]); o[1] = pack2(a[2], a[3]); o[2] = pack2(d[0], d[1]); o[3] = pack2(d[2], d[3]);
                *(u32x4*)(H + (size_t)tt * D + c) = o; }
        }
    }
}

template <bool BF> DI void pool_phase(const Params& p, const void* x, const float* gain) {
    unsigned char* const ws = wsp(p);
    const int bid = opaque_bid();
    bf16_t* H = (bf16_t*)(ws + OFF_H); const float* rstd = (const float*)(ws + OFF_RSTD);
    const int tid = opaque_tid(), g = tid >> 7, left = 1 << g, right = (1 << g) - 1;
    const f32x4 gn = ((const f32x4*)gain)[tid];
    const int per = (T + gridDim.x - 1) / gridDim.x;
    if (gridDim.x == 256) {
        const int tb = bid * 64;
        f32x4 sm[4]; int pl[4], ph[4];
#pragma unroll
        for (int c = 0; c < 4; ++c) {
            const int t = tb + 16 * c, b = t / S, s = t - b * S;
            const int lo = max(s - left, 0), hi = min(s + right + 1, S);
            sm[c] = (f32x4){0.f, 0.f, 0.f, 0.f};
            for (int u = lo; u < hi; ++u) { const int tu = b * S + u; sm[c] += ldx4<BF>(x, (size_t)tu * D + tid * 4) * rstd[tu]; }
            pl[c] = lo; ph[c] = hi;
        }
        for (int i = 0; i < 16; ++i) {
            f32x4 va[4], vs[4], vm[4]; float ra[4], rs[4], rm[4], rc[4];
#pragma unroll
            for (int c = 0; c < 4; ++c) {
                const int t = tb + 16 * c + i, b = t / S, s = t - b * S;
                const int lo = max(s - left, 0), hi = min(s + right + 1, S);
                const int ta = b * S + hi - 1, ts = b * S + pl[c];
                va[c] = ldx4<BF>(x, (size_t)ta * D + tid * 4); vs[c] = ldx4<BF>(x, (size_t)ts * D + tid * 4); vm[c] = ldx4<BF>(x, (size_t)t * D + tid * 4);
                ra[c] = (i > 0 && hi > ph[c]) ? rstd[ta] : 0.f; rs[c] = (i > 0 && lo > pl[c]) ? rstd[ts] : 0.f; rm[c] = rstd[t];
                rc[c] = 1.0f / (float)(hi - lo); pl[c] = lo; ph[c] = hi;
            }
#pragma unroll
            for (int c = 0; c < 4; ++c) {
                const int t = tb + 16 * c + i;
                sm[c] += va[c] * ra[c] - vs[c] * rs[c];
                const f32x4 o = (sm[c] * rc[c] - vm[c] * rm[c]) * gn;
                u32x2 w; w[0] = pack2(o[0], o[1]); w[1] = pack2(o[2], o[3]);
                *(u32x2*)(H + (size_t)t * D + tid * 4) = w;
            }
        }
        return;
    }
    const int t0 = bid * per, t1 = min((bid + 1) * per, T);
    f32x4 sum = {0.f, 0.f, 0.f, 0.f}; int plo = 0, phi = 0;
    for (int t = t0; t < t1; ++t) {
        const int b = t / S, s = t - b * S;
        const int lo = max(s - left, 0), hi = min(s + right + 1, S);
        if (t == t0 || s == 0) {
            sum = (f32x4){0.f, 0.f, 0.f, 0.f};
            for (int u = lo; u < hi; ++u) { const int tu = b * S + u; const float r = rstd[tu]; const f32x4 v = ldx4<BF>(x, (size_t)tu * D + tid * 4); sum += v * r; }
        } else {
            if (hi > phi) { const int tu = b * S + hi - 1; sum += ldx4<BF>(x, (size_t)tu * D + tid * 4) * rstd[tu]; }
            if (lo > plo) { const int tu = b * S + plo;    sum -= ldx4<BF>(x, (size_t)tu * D + tid * 4) * rstd[tu]; }
        }
        plo = lo; phi = hi;
        const float rc = 1.0f / (float)(hi - lo);
        const f32x4 me = ldx4<BF>(x, (size_t)t * D + tid * 4) * rstd[t];
        const f32x4 o = (sum * rc - me) * gn;
        u32x2 w; w[0] = pack2(o[0], o[1]); w[1] = pack2(o[2], o[3]);
        *(u32x2*)(H + (size_t)t * D + tid * 4) = w;
    }
}

DI void glu_phase(const Params& p, int layer) {
    unsigned char* const ws = wsp(p);
    const int bid = opaque_bid();
    const bf16_t* U = (const bf16_t*)(ws + OFF_U); bf16_t* ACT = (bf16_t*)(ws + OFF_ACT);
    const float* cw = p.ffn_conv_w + (size_t)layer * 3 * DFF; const float* cb = p.ffn_conv_b + (size_t)layer * DFF;
    constexpr int NFG = DFF / 8, CH = 32, NTC = T / CH;
    const int tid = opaque_tid();
    for (int task = bid * 512 + tid; task < NFG * NTC; task += gridDim.x * 512) {
        const int tc = task / NFG, fg = task - tc * NFG, f0 = fg * 8, t0 = tc * CH;
        float w0[8], w1[8], w2[8], bb[8];
#pragma unroll
        for (int q = 0; q < 2; ++q) { const f32x4 a = *(const f32x4*)(cw + f0 + 4 * q), b = *(const f32x4*)(cw + DFF + f0 + 4 * q), c = *(const f32x4*)(cw + 2 * DFF + f0 + 4 * q), d = *(const f32x4*)(cb + f0 + 4 * q);
#pragma unroll
            for (int e = 0; e < 4; ++e) { w0[4 * q + e] = a[e]; w1[4 * q + e] = b[e]; w2[4 * q + e] = c[e]; bb[4 * q + e] = d[e]; } }
        const int s0 = t0 & (S - 1);
        u32x4 prev = {0u, 0u, 0u, 0u}, cur, nxt;
        if (s0 != 0) prev = *(const u32x4*)(U + (size_t)(t0 - 1) * 11264 + f0);
        cur = *(const u32x4*)(U + (size_t)t0 * 11264 + f0);
        for (int i = 0; i < CH; ++i) {
            const int t = t0 + i, s = s0 + i;
            nxt = (u32x4){0u, 0u, 0u, 0u};
            if (s != S - 1) nxt = *(const u32x4*)(U + (size_t)(t + 1) * 11264 + f0);
            const u32x4 vv = *(const u32x4*)(U + (size_t)t * 11264 + DFF + f0);
            u32x4 o;
#pragma unroll
            for (int q = 0; q < 4; ++q) {
                const float g0 = w0[2 * q] * bflo(prev[q]) + w1[2 * q] * bflo(cur[q]) + w2[2 * q] * bflo(nxt[q]) + bb[2 * q];
                const float g1 = w0[2 * q + 1] * bfhi(prev[q]) + w1[2 * q + 1] * bfhi(cur[q]) + w2[2 * q + 1] * bfhi(nxt[q]) + bb[2 * q + 1];
                const float a0 = g0 / (1.0f + __expf(-g0)) * bflo(vv[q]);
                const float a1 = g1 / (1.0f + __expf(-g1)) * bfhi(vv[q]);
                o[q] = pack2(a0, a1);
            }
            *(u32x4*)(ACT + (size_t)t * DFF + f0) = o;
            prev = cur; cur = nxt;
        }
    }
}

DI void glu_fix_phase(const Params& p, int layer) {
    unsigned char* const ws = wsp(p);
    const int bid = opaque_bid(), tid = opaque_tid();
    bf16_t* ACT = (bf16_t*)(ws + OFF_ACT);
    const float* EP = (const float*)(ws + OFF_EP); const float* ER = (const float*)(ws + OFF_ER); const float* EV = (const float*)(ws + OFF_EV);
    const float* cw = p.ffn_conv_w + (size_t)layer * 3 * DFF;
    constexpr int NC4 = DFF / 4;
    for (int task = bid * 512 + tid; task < 512 * NC4; task += gridDim.x * 512) {
        const int e = task / NC4, c = (task - e * NC4) * 4, b64 = e >> 1, last = e & 1, row = b64 * 64 + (last ? 63 : 0), sq = row & (S - 1);
        f32x4 gc = *(const f32x4*)(EP + (size_t)e * DFF + c);
        const f32x4 v = *(const f32x4*)(EV + (size_t)e * DFF + c);
        if (!last) { if (sq != 0) { const f32x4 nb = *(const f32x4*)(ER + (size_t)(e - 1) * DFF + c); gc += *(const f32x4*)(cw + c) * nb; } }
        else       { if (sq != S - 1) { const f32x4 nb = *(const f32x4*)(ER + (size_t)(e + 1) * DFF + c); gc += *(const f32x4*)(cw + 2 * DFF + c) * nb; } }
        u32x2 o;
        o[0] = pack2(gc[0] / (1.0f + __expf(-gc[0])) * v[0], gc[1] / (1.0f + __expf(-gc[1])) * v[1]);
        o[1] = pack2(gc[2] / (1.0f + __expf(-gc[2])) * v[2], gc[3] / (1.0f + __expf(-gc[3])) * v[3]);
        *(u32x2*)(ACT + (size_t)row * DFF + c) = o;
    }
}

DI void swa_prep_phase(const Params& p) {
    unsigned char* const ws = wsp(p);
    const int bid = opaque_bid();
    const bf16_t* QKV = (const bf16_t*)(ws + OFF_QKV32);
    bf16_t* QS = (bf16_t*)(ws + OFF_QS); bf16_t* KS = (bf16_t*)(ws + OFF_KS); bf16_t* VTS = (bf16_t*)(ws + OFF_VTS);
    const int tid = opaque_tid(), wid = tid >> 6, lane = tid & 63;
    const float qsc = 0.125f * LOG2E;
    const int tstep = gridDim.x * 8;
    for (int t0 = bid * 8 + wid; t0 < T; t0 += 2 * tstep)
      {
        u32x2 wl[2][9];
#pragma unroll
        for (int q2 = 0; q2 < 2; ++q2) { const int tq = t0 + q2 * tstep; if (tq < T) {
#pragma unroll
            for (int it = 0; it < 9; ++it) wl[q2][it] = *(const u32x2*)(QKV + (size_t)tq * 2560 + it * 256 + lane * 4); } }
#pragma unroll
      for (int q2 = 0; q2 < 2; ++q2) { const int t = t0 + q2 * tstep; if (t < T) {
        const int b = t / S, s = t - b * S;
#pragma unroll
        for (int it = 0; it < 9; ++it) {
            const int col = it * 256 + lane * 4;
            const u32x2 wv = wl[q2][it]; const f32x4 v = {bflo(wv[0]), bfhi(wv[0]), bflo(wv[1]), bfhi(wv[1])};
            float ss = v[0] * v[0] + v[1] * v[1] + v[2] * v[2] + v[3] * v[3];
            ss = sum16(ss);
            const float rs = rsqrtf(ss * (1.0f / 64.f) + EPS);
            const int d = col & 63;
            if (it < 8) { const f32x4 g = *(const f32x4*)(p.swa_q_gain + d); const float f = rs * qsc;
                u32x2 o; o[0] = pack2(v[0] * f * g[0], v[1] * f * g[1]); o[1] = pack2(v[2] * f * g[2], v[3] * f * g[3]);
                *(u32x2*)(QS + (size_t)t * 2048 + col) = o; }
            else { const f32x4 g = *(const f32x4*)(p.swa_k_gain + d); const int kvh = (col - 2048) >> 6;
                u32x2 o; o[0] = pack2(v[0] * rs * g[0], v[1] * rs * g[1]); o[1] = pack2(v[2] * rs * g[2], v[3] * rs * g[3]);
                *(u32x2*)(KS + ((size_t)(b * 4 + kvh) * S + s) * 64 + d) = o; }
        }
      } }
      }
    for (int ch = bid; ch < T / 64; ch += gridDim.x) {
        const int c = tid & 255, kvh = c >> 6, d = c & 63, tq = tid >> 8;
#pragma unroll
        for (int gi = 0; gi < 4; ++gi) {
            const int t0 = ch * 64 + (tq + 2 * gi) * 8, b = t0 / S, s0 = t0 - b * S;
            unsigned v[8];
#pragma unroll
            for (int e = 0; e < 8; ++e) v[e] = QKV[(size_t)(t0 + e) * 2560 + 2304 + c];
            u32x4 o; o[0] = v[0] | (v[1] << 16); o[1] = v[2] | (v[3] << 16); o[2] = v[4] | (v[5] << 16); o[3] = v[6] | (v[7] << 16);
            *(u32x4*)(VTS + ((size_t)(b * 4 + kvh) * 64 + d) * S + s0) = o;
        }
    }
}

template <int NDB, int VSTR>
DI void softmax_pv(const f32x16& sacc, float& m, float& l, f32x16 (&oacc)[NDB], LAS const unsigned char* vptr) {
    float mx = sacc[0];
#pragma unroll
    for (int i = 1; i < 16; ++i) mx = fmaxf(mx, sacc[i]);
    mx = xmax32(mx);
    if (__any(mx > m + 8.0f)) {
        const float mn = fmaxf(m, mx), alpha = fast_exp2(m - mn);
        l *= alpha; m = mn;
#pragma unroll
        for (int db = 0; db < NDB; ++db)
#pragma unroll
            for (int i = 0; i < 16; ++i) oacc[db][i] *= alpha;
    }
    float pv[16], ls = 0.f;
#pragma unroll
    for (int i = 0; i < 16; ++i) { pv[i] = fast_exp2(sacc[i] - m); ls += pv[i]; }
    l += ls;
#pragma unroll
    for (int s2 = 0; s2 < 2; ++s2) {
        u32x4 pw;
#pragma unroll
        for (int q = 0; q < 4; ++q) pw[q] = pack2(pv[8 * s2 + 2 * q], pv[8 * s2 + 2 * q + 1]);
        const bf16x8 pf = __builtin_bit_cast(bf16x8, pw);
#pragma unroll
        for (int db = 0; db < NDB; ++db) {
            const s16x4 lo = *(LAS const s16x4*)(vptr + db * 32 * VSTR + s2 * 32);
            const s16x4 hi = *(LAS const s16x4*)(vptr + db * 32 * VSTR + s2 * 32 + 16);
            const bf16x8 vf = __builtin_shufflevector(lo, hi, 0, 1, 2, 3, 4, 5, 6, 7);
            oacc[db] = __builtin_amdgcn_mfma_f32_32x32x16_bf16(vf, pf, oacc[db], 0, 0, 0);
        }
    }
}

template <int NDB, int VSTR>
DI void load_vfrags(bf16x8 (&vf)[2][NDB], LAS const unsigned char* vptr) {
#pragma unroll
    for (int s2 = 0; s2 < 2; ++s2)
#pragma unroll
        for (int db = 0; db < NDB; ++db) {
            const s16x4 lo = *(LAS const s16x4*)(vptr + db * 32 * VSTR + s2 * 32);
            const s16x4 hi = *(LAS const s16x4*)(vptr + db * 32 * VSTR + s2 * 32 + 16);
            vf[s2][db] = __builtin_shufflevector(lo, hi, 0, 1, 2, 3, 4, 5, 6, 7);
        }
}
template <int NDB>
DI void softmax_only(f32x16& sacc, float& m, float& l, f32x16 (&oacc)[NDB], bf16x8 (&pf)[2]) {
    float mx = sacc[0];
#pragma unroll
    for (int i = 1; i < 16; ++i) mx = fmaxf(mx, sacc[i]);
    mx = xmax32(mx);
    if (__any(mx > 8.0f)) {
        const float d = fmaxf(mx, 0.f), alpha = fast_exp2(-d);
        l *= alpha; m += d;
#pragma unroll
        for (int i = 0; i < 16; ++i) sacc[i] -= d;
#pragma unroll
        for (int db = 0; db < NDB; ++db)
#pragma unroll
            for (int i = 0; i < 16; ++i) oacc[db][i] *= alpha;
    }
    float pv[16], ls = 0.f;
#pragma unroll
    for (int i = 0; i < 16; ++i) { pv[i] = fast_exp2(sacc[i]); ls += pv[i]; }
    l += ls;
#pragma unroll
    for (int s2 = 0; s2 < 2; ++s2) {
        u32x4 pw;
#pragma unroll
        for (int q = 0; q < 4; ++q) pw[q] = pack2(pv[8 * s2 + 2 * q], pv[8 * s2 + 2 * q + 1]);
        pf[s2] = __builtin_bit_cast(bf16x8, pw);
    }
}

DI void swa_attn_phase(const Params& p, LAS unsigned char* lds) {
    unsigned char* const ws = wsp(p);
    const int bid = opaque_bid();
    constexpr int KSTR = 144, VSTR = 584, VOFF = 288 * KSTR;
    const bf16_t* QS = (const bf16_t*)(ws + OFF_QS); const bf16_t* KS = (const bf16_t*)(ws + OFF_KS); const bf16_t* VTS = (const bf16_t*)(ws + OFF_VTS);
    bf16_t* O = (bf16_t*)(ws + OFF_H);
    const int tid = opaque_tid(), wid = tid >> 6, lane = tid & 63, r = lane & 31, h = lane >> 5;
    for (int it0 = bid; it0 < 2048; it0 += gridDim.x) {
        const int item = (gridDim.x == 256) ? (((it0 >> 8) * 8 + (it0 & 7)) * 32 + ((it0 & 255) >> 3)) : it0;
        const int b = item >> 9, kvh = (item >> 7) & 3, qb = item & 127, q0 = qb * 32, kstart = q0 - 128;
        const bf16_t* Kg = KS + (size_t)(b * 4 + kvh) * S * 64; const bf16_t* Vg = VTS + (size_t)(b * 4 + kvh) * 64 * S;
        for (int c = tid; c < 2304; c += 512) { const int row = c >> 3, cc = c & 7, key = kstart + row;
            if (key >= 0 && key < S) *(LAS u32x4*)(lds + row * KSTR + cc * 16) = *(const u32x4*)(Kg + (size_t)key * 64 + cc * 8); }
        for (int c = tid; c < 2304; c += 512) { const int row = c / 36, cc = c - row * 36, key0 = kstart + cc * 8;
            if (key0 >= 0 && key0 < S) { const u32x4 v = *(const u32x4*)(Vg + (size_t)row * S + key0);
                LAS u32x2* dp = (LAS u32x2*)(lds + VOFF + row * VSTR + cc * 16); dp[0] = (u32x2){v[0], v[1]}; dp[1] = (u32x2){v[2], v[3]}; } }
        __syncthreads();
        const int hq = kvh * 8 + wid;
        const float slope2 = exp2f(-(float)(hq + 1) * 0.25f) * LOG2E, sink2 = p.swa_sinks[hq] * LOG2E;
        const bf16_t* Qp = QS + (size_t)(b * S + q0 + r) * 2048 + hq * 64 + 8 * h;
        bf16x8 qf[4];
#pragma unroll
        for (int ks = 0; ks < 4; ++ks) qf[ks] = *(const bf16x8*)(Qp + 16 * ks);
        const int qi = q0 + r, pq = p.positions[qi];
        float m = sink2, l = 0.f;
        f32x16 oacc[2];
#pragma unroll
        for (int db = 0; db < 2; ++db)
#pragma unroll
            for (int i = 0; i < 16; ++i) oacc[db][i] = 0.f;
        for (int blk = 0; blk < 9; ++blk) {
            const int k0 = kstart + blk * 32;
            if (k0 < 0 || k0 >= S) continue;
            f32x16 sacc;
#pragma unroll
            for (int i = 0; i < 16; ++i) sacc[i] = 0.f;
#pragma unroll
            for (int ks = 0; ks < 4; ++ks) { const bf16x8 a = *(LAS const bf16x8*)(lds + (blk * 32 + r) * KSTR + ks * 32 + h * 16);
                sacc = __builtin_amdgcn_mfma_f32_32x32x16_bf16(a, qf[ks], sacc, 0, 0, 0); }
#pragma unroll
            for (int i = 0; i < 16; ++i) { const int key = k0 + (i & 3) + 8 * (i >> 2) + 4 * h;
                const int dk = qi - key, dp = pq - p.positions[key];
                const float sv = sacc[i] - slope2 * (float)(dp < 0 ? -dp : dp);
                sacc[i] = ((dk < 0 ? -dk : dk) <= 128) ? sv : -INFINITY; }
            softmax_pv<2, VSTR>(sacc, m, l, oacc, lds + VOFF + r * VSTR + (blk * 32 + 4 * h) * 2);
        }
        const float lt = xsum32(l) + fast_exp2(sink2 - m), inv = 1.0f / lt;
        bf16_t* Op = O + (size_t)(b * S + qi) * 2048 + hq * 64 + 4 * h;
#pragma unroll
        for (int db = 0; db < 2; ++db)
#pragma unroll
            for (int g = 0; g < 4; ++g) { u32x2 o; o[0] = pack2(oacc[db][4 * g] * inv, oacc[db][4 * g + 1] * inv); o[1] = pack2(oacc[db][4 * g + 2] * inv, oacc[db][4 * g + 3] * inv);
                *(u32x2*)(Op + db * 32 + 8 * g) = o; }
        __syncthreads();
    }
}

DI void mla_prep1_phase(const Params& p) {
    unsigned char* const ws = wsp(p);
    const int bid = opaque_bid();
    const bf16_t* D32 = (const bf16_t*)(ws + OFF_D32);
    bf16_t* CQ = (bf16_t*)(ws + OFF_CQ); bf16_t* CKV = (bf16_t*)(ws + OFF_CKV); bf16_t* KPE = (bf16_t*)(ws + OFF_KPE);
    const float* ct = (const float*)(ws + OFF_ROPE); const float* st = ct + S * 32;
    const int tid = opaque_tid(), wid = tid >> 6, lane = tid & 63;
    const int tstep = gridDim.x * 8;
    for (int t0 = bid * 8 + wid; t0 < T; t0 += 2 * tstep)
      {
        u32x2 wl[2][4]; unsigned short kx[2];
#pragma unroll
        for (int q2 = 0; q2 < 2; ++q2) { const int tq = t0 + q2 * tstep; if (tq < T) { const bf16_t* rw = D32 + (size_t)tq * 1280;
#pragma unroll
            for (int part = 0; part < 2; ++part) { wl[q2][2 * part] = *(const u32x2*)(rw + part * 512 + lane * 4); wl[q2][2 * part + 1] = *(const u32x2*)(rw + part * 512 + 256 + lane * 4); }
            kx[q2] = rw[1024 + lane]; } }
#pragma unroll
      for (int q2 = 0; q2 < 2; ++q2) { const int t = t0 + q2 * tstep; if (t < T) {
        const int s = t & (S - 1);
#pragma unroll
        for (int part = 0; part < 2; ++part) {
            const u32x2 wa = wl[q2][2 * part], wc2 = wl[q2][2 * part + 1];
            const f32x4 a = {bflo(wa[0]), bfhi(wa[0]), bflo(wa[1]), bfhi(wa[1])}, c = {bflo(wc2[0]), bfhi(wc2[0]), bflo(wc2[1]), bfhi(wc2[1])};
            float ss = a[0] * a[0] + a[1] * a[1] + a[2] * a[2] + a[3] * a[3] + c[0] * c[0] + c[1] * c[1] + c[2] * c[2] + c[3] * c[3];
            ss = wave_sum(ss);
            const float rs = rsqrtf(ss * (1.0f / 512.f) + EPS);
            const float* gp = part ? p.mla_kv_a_gain : p.mla_q_a_gain; bf16_t* dst = (part ? CKV : CQ) + (size_t)t * 512;
            const f32x4 g0 = *(const f32x4*)(gp + lane * 4), g1 = *(const f32x4*)(gp + 256 + lane * 4);
            u32x2 o0, o1; o0[0] = pack2(a[0] * rs * g0[0], a[1] * rs * g0[1]); o0[1] = pack2(a[2] * rs * g0[2], a[3] * rs * g0[3]);
            o1[0] = pack2(c[0] * rs * g1[0], c[1] * rs * g1[1]); o1[1] = pack2(c[2] * rs * g1[2], c[3] * rs * g1[3]);
            *(u32x2*)(dst + lane * 4) = o0; *(u32x2*)(dst + 256 + lane * 4) = o1;
        }
        const float x = bf2f(kx[q2]);
        const float ss = wave_sum(x * x);
        const float xn = x * rsqrtf(ss * (1.0f / 64.f) + EPS) * p.mla_kr_gain[lane];
        const float pr = __shfl_xor(xn, 32);
        const float cc = ct[s * 32 + (lane & 31)], sn = st[s * 32 + (lane & 31)];
        const float o = lane < 32 ? xn * cc - pr * sn : xn * cc + pr * sn;
        KPE[(size_t)t * 64 + lane] = f2bf(o);
      } }
      }
}

DI void mla_prep2_phase(const Params& p) {
    unsigned char* const ws = wsp(p);
    const int bid = opaque_bid();
    const bf16_t* Q32 = (const bf16_t*)(ws + OFF_Q32); const bf16_t* KV32 = (const bf16_t*)(ws + OFF_KV32); const bf16_t* KPE = (const bf16_t*)(ws + OFF_KPE);
    bf16_t* QN = (bf16_t*)(ws + OFF_QN); bf16_t* KC = (bf16_t*)(ws + OFF_KC); bf16_t* VT = (bf16_t*)(ws + OFF_VT);
    const float* ct = (const float*)(ws + OFF_ROPE); const float* st = ct + S * 32;
    const int tid = opaque_tid(), wid = tid >> 6, lane = tid & 63;
    const float qsc = 0.07216878364870322f * LOG2E;
    const int j = lane & 15, hsub = lane >> 4;
    float gqn[8], gkn[8], gqr[4];
#pragma unroll
    for (int e = 0; e < 8; ++e) { gqn[e] = p.mla_qn_gain[8 * j + e]; gkn[e] = p.mla_kn_gain[8 * j + e]; }
#pragma unroll
    for (int e = 0; e < 4; ++e) gqr[e] = p.mla_qr_gain[4 * j + e];
    const int tstride = gridDim.x * 8;
    for (int task0 = bid * 8 + wid; task0 < T * 4; task0 += 4 * tstride) {
        u32x4 wq4[4], wk4[4]; u32x2 wp4[4], kp4[4];
#pragma unroll
        for (int u = 0; u < 4; ++u) {
            const int task = task0 + u * tstride;
            if (task < T * 4) {
                const int t = task >> 2, hh = (task & 3) * 4 + hsub;
                const bf16_t* qrow = Q32 + (size_t)t * 3072 + hh * 192; const bf16_t* kvrow = KV32 + (size_t)t * 4096 + hh * 256;
                wq4[u] = *(const u32x4*)(qrow + 8 * j); wk4[u] = *(const u32x4*)(kvrow + 8 * j);
                wp4[u] = *(const u32x2*)(qrow + 128 + 4 * j); kp4[u] = *(const u32x2*)(KPE + (size_t)t * 64 + 4 * j);
            }
        }
#pragma unroll
        for (int u = 0; u < 4; ++u) {
            const int task = task0 + u * tstride;
            if (task < T * 4) {
                const int t = task >> 2, hh = (task & 3) * 4 + hsub, b = t / S, s = t - b * S;
                const size_t ob = ((size_t)(b * 16 + hh) * S + s) * 192;
                const u32x4 wq = wq4[u], wk = wk4[u]; const u32x2 wp = wp4[u], kp = kp4[u];
                float q[8], k[8], x[4];
#pragma unroll
                for (int e = 0; e < 4; ++e) { q[2 * e] = bflo(wq[e]); q[2 * e + 1] = bfhi(wq[e]); k[2 * e] = bflo(wk[e]); k[2 * e + 1] = bfhi(wk[e]); }
                x[0] = bflo(wp[0]); x[1] = bfhi(wp[0]); x[2] = bflo(wp[1]); x[3] = bfhi(wp[1]);
                float sq = 0.f, sk = 0.f, sx = 0.f;
#pragma unroll
                for (int e = 0; e < 8; ++e) { sq += q[e] * q[e]; sk += k[e] * k[e]; }
#pragma unroll
                for (int e = 0; e < 4; ++e) sx += x[e] * x[e];
                sq = sum16(sq); sk = sum16(sk); sx = sum16(sx);
                const float fq = rsqrtf(sq * (1.0f / 128.f) + EPS) * qsc, fk = rsqrtf(sk * (1.0f / 128.f) + EPS), fx = rsqrtf(sx * (1.0f / 64.f) + EPS);
                u32x4 oq, ok;
#pragma unroll
                for (int e = 0; e < 4; ++e) { oq[e] = pack2(q[2 * e] * fq * gqn[2 * e], q[2 * e + 1] * fq * gqn[2 * e + 1]); ok[e] = pack2(k[2 * e] * fk * gkn[2 * e], k[2 * e + 1] * fk * gkn[2 * e + 1]); }
                *(u32x4*)(QN + ob + 8 * j) = oq; *(u32x4*)(KC + ob + 8 * j) = ok;
                float ro[4];
#pragma unroll
                for (int e = 0; e < 4; ++e) { const float xn = x[e] * fx * gqr[e], pr = dppf<0x128>(xn);
                    const int fi = (4 * j + e) & 31; const float cc = ct[s * 32 + fi], sn = st[s * 32 + fi];
                    ro[e] = (j < 8 ? xn * cc - pr * sn : xn * cc + pr * sn) * qsc; }
                u32x2 op; op[0] = pack2(ro[0], ro[1]); op[1] = pack2(ro[2], ro[3]);
                *(u32x2*)(QN + ob + 128 + 4 * j) = op;
                *(u32x2*)(KC + ob + 128 + 4 * j) = kp;
            }
        }
    }
    for (int bt = bid; bt < (T / 64) * 16; bt += gridDim.x) {
        const int ch = bt >> 4, hh = bt & 15, dv = tid & 127, tq = tid >> 7;
#pragma unroll
        for (int gi = 0; gi < 2; ++gi) {
            const int t0 = ch * 64 + (tq + 4 * gi) * 8, b = t0 / S, s0 = t0 - b * S;
            unsigned v[8];
#pragma unroll
            for (int e = 0; e < 8; ++e) v[e] = KV32[(size_t)(t0 + e) * 4096 + hh * 256 + 128 + dv];
            u32x4 o; o[0] = v[0] | (v[1] << 16); o[1] = v[2] | (v[3] << 16); o[2] = v[4] | (v[5] << 16); o[3] = v[6] | (v[7] << 16);
            *(u32x4*)(VT + ((size_t)(b * 16 + hh) * 128 + dv) * S + s0) = o;
        }
    }
}

DI void mla_attn_phase(const Params& p, LAS unsigned char* lds) {
    unsigned char* const ws = wsp(p);
    const int bid = opaque_bid();
    constexpr int KSTR = 400, VSTR = 136, KBUF = 64 * KSTR, VBUF = 128 * VSTR, BUF = KBUF + VBUF, NT = S / 64;
    const bf16_t* QN = (const bf16_t*)(ws + OFF_QN); const bf16_t* KC = (const bf16_t*)(ws + OFF_KC); const bf16_t* VT = (const bf16_t*)(ws + OFF_VT);
    bf16_t* O = (bf16_t*)(ws + OFF_H);
    const int tid = opaque_tid(), wid = tid >> 6, lane = tid & 63, r = lane & 31, h = lane >> 5;
    unsigned klds[3], vlds[2], vgo[2];
#pragma unroll
    for (int i = 0; i < 3; ++i) { const int c = tid + 512 * i, kr = c / 24; klds[i] = (unsigned)(kr * KSTR + (c - kr * 24) * 16); }
#pragma unroll
    for (int i = 0; i < 2; ++i) { const int c = tid + 512 * i, vr = c >> 3, vc = c & 7; vlds[i] = (unsigned)(KBUF + vr * VSTR + vc * 16); vgo[i] = (unsigned)((vr * S + vc * 8) * 2); }
    const unsigned kgo = (unsigned)tid * 16u;
    for (int it0 = bid; it0 < 1024; it0 += gridDim.x) {
        const int item = (gridDim.x == 256) ? (((it0 >> 8) * 8 + (it0 & 7)) * 32 + ((it0 & 255) >> 3)) : it0;
        const int bh = item >> 4, qb = item & 15, b = bh >> 4, hh = bh & 15, q0 = qb * 256 + wid * 32;
        const char* Kg = (const char*)(KC + (size_t)bh * S * 192); const char* Vg = (const char*)(VT + (size_t)bh * 128 * S);
        const bf16_t* Qp = QN + ((size_t)bh * S + q0 + r) * 192 + 8 * h;
        bf16x8 qf[12];
#pragma unroll
        for (int ks = 0; ks < 12; ++ks) qf[ks] = *(const bf16x8*)(Qp + 16 * ks);
        u32x4 kreg[3], vreg[2];
#define MLA_LOAD(k0) do { const char* kt_ = Kg + (size_t)(k0) * 384; const char* vt_ = Vg + (size_t)(k0) * 2; \
                          _Pragma("unroll") for (int i = 0; i < 3; ++i) kreg[i] = *(const u32x4*)(kt_ + kgo + i * 8192); \
                          _Pragma("unroll") for (int i = 0; i < 2; ++i) vreg[i] = *(const u32x4*)(vt_ + vgo[i]); } while (0)
#define MLA_STORE(bufp) do { _Pragma("unroll") for (int i = 0; i < 3; ++i) *(LAS u32x4*)((bufp) + klds[i]) = kreg[i]; \
                             _Pragma("unroll") for (int i = 0; i < 2; ++i) { LAS u32x2* dp = (LAS u32x2*)((bufp) + vlds[i]); \
                                 dp[0] = (u32x2){vreg[i][0], vreg[i][1]}; dp[1] = (u32x2){vreg[i][2], vreg[i][3]}; } } while (0)
        MLA_LOAD(0); MLA_STORE(lds);
        __syncthreads();
        float m = 0.f, l = 0.f;
        f32x16 oacc[4];
#pragma unroll
        for (int db = 0; db < 4; ++db)
#pragma unroll
            for (int i = 0; i < 16; ++i) oacc[db][i] = 0.f;
        for (int t = 0; t < NT; ++t) {
            if (t + 1 < NT) MLA_LOAD((t + 1) * 64);
            LAS unsigned char* kb = lds + (t & 1) * BUF;
#pragma unroll
            for (int blk = 0; blk < 2; ++blk) {
                bf16x8 kf[12];
                LAS const unsigned char* kp = kb + (blk * 32 + r) * KSTR + h * 16;
#pragma unroll
                for (int ks = 0; ks < 4; ++ks) kf[ks] = *(LAS const bf16x8*)(kp + ks * 32);
                f32x16 sacc;
#pragma unroll
                for (int i = 0; i < 16; ++i) sacc[i] = -m;
#pragma unroll
                for (int kg = 0; kg < 3; ++kg) {
                    if (kg < 2) {
#pragma unroll
                        for (int ks = 0; ks < 4; ++ks) kf[4 * (kg + 1) + ks] = *(LAS const bf16x8*)(kp + (4 * (kg + 1) + ks) * 32);
                    }
#pragma unroll
                    for (int ks = 0; ks < 4; ++ks) sacc = __builtin_amdgcn_mfma_f32_32x32x16_bf16(kf[4 * kg + ks], qf[4 * kg + ks], sacc, 0, 0, 0);
                }
                bf16x8 vf[2][4], pf[2];
                load_vfrags<4, VSTR>(vf, kb + KBUF + r * VSTR + (blk * 32 + 4 * h) * 2);
                softmax_only<4>(sacc, m, l, oacc, pf);
#pragma unroll
                for (int s2 = 0; s2 < 2; ++s2)
#pragma unroll
                    for (int db = 0; db < 4; ++db) oacc[db] = __builtin_amdgcn_mfma_f32_32x32x16_bf16(vf[s2][db], pf[s2], oacc[db], 0, 0, 0);
            }
            if (t + 1 < NT) MLA_STORE(lds + ((t + 1) & 1) * BUF);
            __syncthreads();
        }
#undef MLA_LOAD
#undef MLA_STORE
        const float lt = xsum32(l), inv = 1.0f / lt;
        bf16_t* Op = O + (size_t)(b * S + q0 + r) * 2048 + hh * 128 + 4 * h;
#pragma unroll
        for (int db = 0; db < 4; ++db)
#pragma unroll
            for (int g = 0; g < 4; ++g) { u32x2 o; o[0] = pack2(oacc[db][4 * g] * inv, oacc[db][4 * g + 1] * inv); o[1] = pack2(oacc[db][4 * g + 2] * inv, oacc[db][4 * g + 3] * inv);
                *(u32x2*)(Op + db * 32 + 8 * g) = o; }
    }
}

constexpr int BM = 256, BK = 64, HALF = 128, HTB = HALF * BK * 2, NXCD = 8, WGM = 8;
DI int lds_byte(int r, int c) { const int st = (r >> 4) * 2 + (c >> 5), rr = r & 15, cc = c & 31, ob = rr * 64 + cc * 2; return st * 1024 + (ob ^ (((ob >> 9) & 1) << 5)); }
DI int perm32(int rho) { const int n = rho >> 4, i = rho & 15; return 8 * (i >> 2) + 4 * n + (i & 3); }
DI void stage_rc(int b, int& R, int& C) { const int st = b / 1024, sb = b % 1024, swz = sb ^ (((sb >> 9) & 1) << 5); R = (st >> 1) * 16 + swz / 64; C = (st & 1) * 32 + (swz % 64) / 2; }
struct Unit { int pm, pn; };
DI bool sched_next(int i, int nM, int nN, int G, int c, Unit& u) {
    const int nwg = nM * nN; const long L = (long)i * G + c; if (L >= nwg) return false;
    int wgid = (int)L; { const int q = nwg / NXCD, r = nwg % NXCD, xcd = wgid % NXCD, off = wgid / NXCD; wgid = (xcd < r ? xcd * (q + 1) : r * (q + 1) + (xcd - r) * q) + off; }
    const int nig = WGM * nN, gid = wgid / nig, fm = gid * WGM, gsz = (nM - fm) < WGM ? (nM - fm) : WGM;
    u.pm = fm + ((wgid % nig) % gsz); u.pn = (wgid % nig) / gsz; return true;
}

struct EpiF32 {
    static constexpr bool PERM = false;
    float* C; int ldc; float* C2; int ldc2; int split;
    DI void operator()(const f32x4 (&acc)[2][2][4][2], const Unit& u, int wr, int wc, int fr, int fq) const {
        float* base = C; int ld = ldc, pn = u.pn; if (pn >= split) { base = C2; ld = ldc2; pn -= split; }
        const int row0 = u.pm * BM + wr * 64 + fr, col0 = pn * BM + wc * 32 + 4 * fq;
#pragma unroll
        for (int ai = 0; ai < 2; ++ai)
#pragma unroll
            for (int m = 0; m < 4; ++m) { float* rowp = base + (size_t)(row0 + ai * HALF + m * 16) * ld + col0;
#pragma unroll
                for (int bj = 0; bj < 2; ++bj)
#pragma unroll
                    for (int n = 0; n < 2; ++n) *(f32x4*)(rowp + bj * HALF + n * 16) = acc[ai][bj][m][n]; }
    }
};
struct EpiBf16 {
    static constexpr bool PERM = true;
    bf16_t* O1; int ldc1; bf16_t* O2; int ldc2; int split;
    DI void operator()(const f32x4 (&acc)[2][2][4][2], const Unit& u, int wr, int wc, int fr, int fq) const {
        bf16_t* O = O1; int ldc = ldc1, pn = u.pn; if (pn >= split) { O = O2; ldc = ldc2; pn -= split; }
        const int row0 = u.pm * BM + wr * 64 + fr, col0 = pn * BM + wc * 32 + 8 * fq;
#pragma unroll
        for (int ai = 0; ai < 2; ++ai)
#pragma unroll
            for (int m = 0; m < 4; ++m) { bf16_t* rowp = O + (size_t)(row0 + ai * HALF + m * 16) * ldc + col0;
#pragma unroll
                for (int bj = 0; bj < 2; ++bj) { const f32x4 v0 = acc[ai][bj][m][0], v1 = acc[ai][bj][m][1];
                    u32x4 o; o[0] = pack2(v0[0], v0[1]); o[1] = pack2(v0[2], v0[3]); o[2] = pack2(v1[0], v1[1]); o[3] = pack2(v1[2], v1[3]);
                    *(u32x4*)(rowp + bj * HALF) = o; } }
    }
};
template <bool IB, bool OB> struct EpiRes {
    static constexpr bool PERM = true;
    const void* Xin; void* Xout; const float* scale;
    DI void operator()(const f32x4 (&acc)[2][2][4][2], const Unit& u, int wr, int wc, int fr, int fq) const {
        const int row0 = u.pm * BM + wr * 64 + fr, col0 = u.pn * BM + wc * 32 + 8 * fq;
        f32x4 sc[2][2];
#pragma unroll
        for (int bj = 0; bj < 2; ++bj)
#pragma unroll
            for (int n = 0; n < 2; ++n) sc[bj][n] = scale ? *(const f32x4*)(scale + col0 + bj * HALF + 4 * n) : (f32x4){1.f, 1.f, 1.f, 1.f};
#pragma unroll
        for (int ai = 0; ai < 2; ++ai)
#pragma unroll
            for (int m = 0; m < 4; ++m) { const size_t ro = (size_t)(row0 + ai * HALF + m * 16) * D + col0;
#pragma unroll
                for (int bj = 0; bj < 2; ++bj) {
                    f32x4 x0, x1;
                    if constexpr (IB) { const u32x4 w = *(const u32x4*)((const bf16_t*)Xin + ro + bj * HALF);
                        x0 = (f32x4){bflo(w[0]), bfhi(w[0]), bflo(w[1]), bfhi(w[1])}; x1 = (f32x4){bflo(w[2]), bfhi(w[2]), bflo(w[3]), bfhi(w[3])}; }
                    else { x0 = *(const f32x4*)((const float*)Xin + ro + bj * HALF); x1 = *(const f32x4*)((const float*)Xin + ro + bj * HALF + 4); }
                    x0 += acc[ai][bj][m][0] * sc[bj][0]; x1 += acc[ai][bj][m][1] * sc[bj][1];
                    if constexpr (OB) { u32x4 o; o[0] = pack2(x0[0], x0[1]); o[1] = pack2(x0[2], x0[3]); o[2] = pack2(x1[0], x1[1]); o[3] = pack2(x1[2], x1[3]);
                        *(u32x4*)((bf16_t*)Xout + ro + bj * HALF) = o; }
                    else { *(f32x4*)((float*)Xout + ro + bj * HALF) = x0; *(f32x4*)((float*)Xout + ro + bj * HALF + 4) = x1; } } }
    }
};
struct EpiGlu {
    static constexpr bool PERM = true;
    const float* cw; const float* cb; bf16_t* ACT; float* EP; float* ER; float* EV;
    DI void operator()(const f32x4 (&acc)[2][2][4][2], const Unit& u, int wr, int wc, int fr, int fq) const {
        const int row0 = u.pm * BM + wr * 64 + fr, ch0 = u.pn * 128 + wc * 32 + 8 * fq;
        f32x4 w0[2], w1[2], w2[2], bb[2];
#pragma unroll
        for (int n = 0; n < 2; ++n) { w0[n] = *(const f32x4*)(cw + ch0 + 4 * n); w1[n] = *(const f32x4*)(cw + DFF + ch0 + 4 * n); w2[n] = *(const f32x4*)(cw + 2 * DFF + ch0 + 4 * n); bb[n] = *(const f32x4*)(cb + ch0 + 4 * n); }
#pragma unroll
        for (int ai = 0; ai < 2; ++ai)
#pragma unroll
            for (int m = 0; m < 4; ++m) {
                const bool efirst = (m == 0) && (fr == 0), elast = (m == 3) && (fr == 15);
                const int row = row0 + ai * HALF + m * 16;
                f32x4 gc[2];
#pragma unroll
                for (int n = 0; n < 2; ++n) {
                    const f32x4 g = acc[ai][0][m][n];
                    const f32x4 gprev = acc[ai][0][m > 0 ? m - 1 : 0][n], gnext = acc[ai][0][m < 3 ? m + 1 : 3][n];
                    f32x4 up, dn;
#pragma unroll
                    for (int e = 0; e < 4; ++e) {
                        const float pu = (m > 0 && fr == 15) ? gprev[e] : g[e];
                        const float pd = (m < 3 && fr == 0) ? gnext[e] : g[e];
                        up[e] = dpp_ror1(pu); dn[e] = dpp_ror15(pd);
                    }
                    if (efirst) up = (f32x4){0.f, 0.f, 0.f, 0.f};
                    if (elast) dn = (f32x4){0.f, 0.f, 0.f, 0.f};
                    gc[n] = w0[n] * up + w1[n] * g + w2[n] * dn + bb[n];
                }
                if (efirst || elast) {
                    const size_t eo = (size_t)((row >> 6) * 2 + (elast ? 1 : 0)) * DFF + ch0;
#pragma unroll
                    for (int n = 0; n < 2; ++n) { *(f32x4*)(EP + eo + 4 * n) = gc[n]; *(f32x4*)(ER + eo + 4 * n) = acc[ai][0][m][n]; *(f32x4*)(EV + eo + 4 * n) = acc[ai][1][m][n]; }
                } else {
                    const f32x4 v0 = acc[ai][1][m][0], v1 = acc[ai][1][m][1];
                    u32x4 o;
                    o[0] = pack2(silu_mul(gc[0][0], v0[0]), silu_mul(gc[0][1], v0[1])); o[1] = pack2(silu_mul(gc[0][2], v0[2]), silu_mul(gc[0][3], v0[3]));
                    o[2] = pack2(silu_mul(gc[1][0], v1[0]), silu_mul(gc[1][1], v1[1])); o[3] = pack2(silu_mul(gc[1][2], v1[2]), silu_mul(gc[1][3], v1[3]));
                    *(u32x4*)(ACT + (size_t)row * DFF + ch0) = o;
                }
            }
    }
};
struct MapPlain { const bf16_t* A; const bf16_t* B; int lda, ldb;
    DI const char* a(const Unit& u) const { return (const char*)(A + (size_t)u.pm * BM * lda); }
    DI const char* b(const Unit& u) const { return (const char*)(B + (size_t)u.pn * BM * ldb); } };
struct MapPool { const bf16_t* A; const bf16_t* B;
    DI const char* a(const Unit& u) const { return (const char*)(A + (size_t)u.pm * BM * 2048 + (u.pn >> 1) * 512); }
    DI const char* b(const Unit& u) const { return (const char*)(B + ((size_t)(u.pn >> 1) * 512 + (u.pn & 1) * 256) * 512); } };
struct MapUqkv { const bf16_t* A1; const bf16_t* A2; const bf16_t* B1; const bf16_t* B2;
    DI const char* a(const Unit& u) const { return (const char*)((u.pn < 12 ? A1 : A2) + (size_t)u.pm * BM * 512); }
    DI const char* b(const Unit& u) const { return (const char*)(u.pn < 12 ? B1 + (size_t)u.pn * BM * 512 : B2 + (size_t)(u.pn - 12) * BM * 512); } };

template <class Map, class Epi>
DI void gemm_phase(LAS unsigned char* lds, const Map& MP, const Epi& E, const int nM, const int nN, const int K, const int lda, const int ldb) {
    const int tid = opaque_tid(), wid = __builtin_amdgcn_readfirstlane(tid >> 6), lane = tid & 63, wr = wid >> 2, wc = wid & 3, fr = lane & 15, fq = lane >> 4;
    const int nt = K / BK, G = gridDim.x, cblk = opaque_bid();
    unsigned voffA[2], voffB[2];
#pragma unroll
    for (int i = 0; i < 2; ++i) { int R, C; stage_rc(tid * 16 + i * 8192, R, C); const int Rb = Epi::PERM ? ((R & ~31) + perm32(R & 31)) : R;
        voffA[i] = (unsigned)(R * lda + C) * 2u; voffB[i] = (unsigned)(Rb * ldb + C) * 2u; }
    const size_t kstep = (size_t)(BK * 2);
    const size_t hstepA = (size_t)HALF * lda * 2, hstepB = (size_t)HALF * ldb * 2;
    const unsigned ldsw = (unsigned)wid * 1024u;
    const int aoff = lds_byte(wr * 64 + fr, fq * 8), boff = lds_byte(wc * 32 + fr, fq * 8);
#define PG8_SA(b, h) (((b) * 2 + (h)) * HTB)
#define PG8_SB(b, h) ((4 + (b) * 2 + (h)) * HTB)
#define PG8_STAGE(bufoff, gbase, voff) do { _Pragma("unroll") for (int _i = 0; _i < 2; ++_i) \
        __builtin_amdgcn_global_load_lds((const unsigned*)((const char*)(gbase) + (voff)[_i]), (LAS unsigned*)(lds + (bufoff) + ldsw + _i * 8192), 16, 0, 0); } while (0)
#define PG8_LDA(dst, b, h) do { _Pragma("unroll") for (int m = 0; m < 4; ++m) _Pragma("unroll") for (int k = 0; k < 2; ++k) dst[m][k] = *(const LAS bf16x8*)(lds + PG8_SA(b, h) + aoff + m * 2048 + k * 1024); } while (0)
#define PG8_LDB(dst, b, h) do { _Pragma("unroll") for (int n = 0; n < 2; ++n) _Pragma("unroll") for (int k = 0; k < 2; ++k) dst[n][k] = *(const LAS bf16x8*)(lds + PG8_SB(b, h) + boff + n * 2048 + k * 1024); } while (0)
#define PG8_MMA(ai, bj, At, Bt) do { __builtin_amdgcn_s_setprio(1); _Pragma("unroll") for (int m = 0; m < 4; ++m) _Pragma("unroll") for (int n = 0; n < 2; ++n) _Pragma("unroll") for (int k = 0; k < 2; ++k) \
        acc[ai][bj][m][n] = __builtin_amdgcn_mfma_f32_16x16x32_bf16(Bt[n][k], At[m][k], acc[ai][bj][m][n], 0, 0, 0); __builtin_amdgcn_s_setprio(0); } while (0)
#define PG8_WAIT_V(n) asm volatile("s_waitcnt vmcnt(" #n ")" ::: "memory")
#define PG8_WAIT_L(n) asm volatile("s_waitcnt lgkmcnt(" #n ")" ::: "memory")
#define PG8_BAR __builtin_amdgcn_s_barrier()
#define PG8_SCHED __builtin_amdgcn_sched_barrier(0)
    Unit cur, nxt; int ui = 0;
    if (!sched_next(0, nM, nN, G, cblk, cur)) return;
    f32x4 acc[2][2][4][2];
#pragma unroll
    for (int a = 0; a < 2; ++a)
#pragma unroll
        for (int b = 0; b < 2; ++b)
#pragma unroll
            for (int m = 0; m < 4; ++m)
#pragma unroll
                for (int n = 0; n < 2; ++n) acc[a][b][m][n] = (f32x4){0.f, 0.f, 0.f, 0.f};
    bf16x8 At[4][2], B0[2][2], B1[2][2];
    const char* cA = MP.a(cur); const char* cB = MP.b(cur);
    PG8_STAGE(PG8_SB(0, 0), cB, voffB); PG8_STAGE(PG8_SA(0, 0), cA, voffA); PG8_STAGE(PG8_SB(0, 1), cB + hstepB, voffB); PG8_STAGE(PG8_SA(0, 1), cA + hstepA, voffA);
    if (wr == 1) PG8_BAR;
    PG8_WAIT_V(4); PG8_BAR;
    PG8_STAGE(PG8_SB(1, 0), cB + kstep, voffB); PG8_STAGE(PG8_SA(1, 0), cA + kstep, voffA); PG8_STAGE(PG8_SB(1, 1), cB + hstepB + kstep, voffB);
    PG8_WAIT_V(6); PG8_BAR;
    for (;;) {
        const bool has_next = sched_next(ui + 1, nM, nN, G, cblk, nxt);
        const char* nA = has_next ? MP.a(nxt) : cA; const char* nB = has_next ? MP.b(nxt) : cB;
        for (int t = 0; t < nt; t += 2) {
            const bool last = (t == nt - 2);
            const char* a1 = cA + (size_t)(t + 1) * kstep;
            const char* a2 = last ? nA : cA + (size_t)(t + 2) * kstep; const char* b2 = last ? nB : cB + (size_t)(t + 2) * kstep;
            const char* a3 = a2 + kstep; const char* b3 = b2 + kstep;
            PG8_LDB(B0, 0, 0); PG8_SCHED; PG8_LDA(At, 0, 0); PG8_STAGE(PG8_SA(1, 1), a1 + hstepA, voffA);
            PG8_WAIT_L(8); PG8_BAR; PG8_WAIT_L(0); PG8_MMA(0, 0, At, B0); PG8_BAR; PG8_SCHED;
            PG8_LDB(B1, 0, 1); PG8_STAGE(PG8_SB(0, 0), b2, voffB);
            PG8_BAR; PG8_WAIT_L(0); PG8_MMA(0, 1, At, B1); PG8_BAR;
            PG8_LDA(At, 0, 1); PG8_STAGE(PG8_SA(0, 0), a2, voffA);
            PG8_BAR; PG8_WAIT_L(0); PG8_MMA(1, 0, At, B0); PG8_BAR; PG8_SCHED;
            PG8_STAGE(PG8_SB(0, 1), b2 + hstepB, voffB);
            PG8_WAIT_V(6); PG8_BAR; PG8_MMA(1, 1, At, B1); PG8_BAR;
            PG8_LDB(B0, 1, 0); PG8_SCHED; PG8_LDA(At, 1, 0); PG8_STAGE(PG8_SA(0, 1), a2 + hstepA, voffA);
            PG8_WAIT_L(8); PG8_BAR; PG8_WAIT_L(0); PG8_MMA(0, 0, At, B0); PG8_BAR; PG8_SCHED;
            PG8_LDB(B1, 1, 1); PG8_STAGE(PG8_SB(1, 0), b3, voffB);
            PG8_BAR; PG8_WAIT_L(0); PG8_MMA(0, 1, At, B1); PG8_BAR;
            PG8_LDA(At, 1, 1); PG8_STAGE(PG8_SA(1, 0), a3, voffA);
            PG8_BAR; PG8_WAIT_L(0); PG8_MMA(1, 0, At, B0); PG8_BAR; PG8_SCHED;
            PG8_STAGE(PG8_SB(1, 1), b3 + hstepB, voffB);
            PG8_WAIT_V(6); PG8_BAR; PG8_MMA(1, 1, At, B1); PG8_BAR;
        }
        { int frr = fr, fqq = fq; asm volatile("" : "+v"(frr), "+v"(fqq)); E(acc, cur, wr, wc, frr, fqq); }
        if (!has_next) break;
#pragma unroll
        for (int a = 0; a < 2; ++a)
#pragma unroll
            for (int b = 0; b < 2; ++b)
#pragma unroll
                for (int m = 0; m < 4; ++m)
#pragma unroll
                    for (int n = 0; n < 2; ++n) acc[a][b][m][n] = (f32x4){0.f, 0.f, 0.f, 0.f};
        cur = nxt; cA = nA; cB = nB; ++ui;
    }
    PG8_WAIT_V(0);
    if (wr == 0) PG8_BAR;
    PG8_BAR;
#undef PG8_SA
#undef PG8_SB
#undef PG8_STAGE
#undef PG8_LDA
#undef PG8_LDB
#undef PG8_MMA
#undef PG8_WAIT_V
#undef PG8_WAIT_L
#undef PG8_BAR
#undef PG8_SCHED
}


#define XB_TMO      128
#define XB_XCNT(j)  (256  + 64 * (j))
#define XB_XSUB(j)  (1280 + 64 * (j))
#define XB_XGEN(j)  (2304 + 64 * (j))
#define XB_TOP      3328
#define XB_TOPGEN   3392
#define XCD_BAR_WORDS 3456
#define XB_SPIN_CAP (1u << 18)
DI unsigned xb_ld(unsigned* p)              { return __hip_atomic_load(p, __ATOMIC_RELAXED, __HIP_MEMORY_SCOPE_AGENT); }
DI unsigned xb_add(unsigned* p, unsigned v) { return __hip_atomic_fetch_add(p, v, __ATOMIC_RELAXED, __HIP_MEMORY_SCOPE_AGENT); }
DI unsigned xb_xcc_id() { return (unsigned)__builtin_amdgcn_s_getreg((3 << 11) | 20) & 0xFu; }
#define XB_SPIN(cond, bar) do { unsigned _sp = 0; while (cond) { __builtin_amdgcn_s_sleep(1); \
    if ((++_sp & 255u) == 0u) { if (xb_ld(&(bar)[XB_TMO])) break; if (_sp > XB_SPIN_CAP) { atomicAdd(&(bar)[XB_TMO], 1u); break; } } } } while (0)
struct XcdBarrier { unsigned* bar; unsigned x; volatile LAS unsigned* st; };
DI XcdBarrier xcd_barrier_post(unsigned* bar, volatile LAS unsigned* st) {
    XcdBarrier b; b.bar = bar; b.x = xb_xcc_id(); b.st = st;
    if (threadIdx.x == 0) (void)xb_add(&bar[XB_XCNT(b.x)], 1u);
    return b;
}
DI void xcd_barrier_complete(unsigned* bar, unsigned x, unsigned& nloc, unsigned& nx) {
    const unsigned G = gridDim.x * gridDim.y * gridDim.z;
    unsigned sum, cnt, mine, sp = 0u;
    for (;;) {
        sum = 0u; cnt = 0u; mine = 0u;
#pragma unroll
        for (unsigned j = 0; j < 16; ++j) { const unsigned c = xb_ld(&bar[XB_XCNT(j)]); sum += c; cnt += (c > 0u) ? 1u : 0u; mine = (j == x) ? c : mine; }
        if (sum == G) break;
        __builtin_amdgcn_s_sleep(1);
        if ((++sp & 255u) == 0u) { if (xb_ld(&bar[XB_TMO])) break; if (sp > XB_SPIN_CAP) { atomicAdd(&bar[XB_TMO], 1u); break; } }
    }
    nloc = mine > 0u ? mine : 1u; nx = cnt > 0u ? cnt : 1u;
}
DI void xcd_barrier(const XcdBarrier& b) {
    asm volatile("s_waitcnt vmcnt(0)" ::: "memory");
    __syncthreads();
    if (threadIdx.x == 0) {
        unsigned* bar = b.bar;
        __builtin_amdgcn_s_waitcnt(0);
        unsigned nloc = b.st[0], nx = b.st[1];
        if (nloc == 0u) { xcd_barrier_complete(bar, b.x, nloc, nx); b.st[0] = nloc; b.st[1] = nx; }
        const unsigned old = xb_add(&bar[XB_XSUB(b.x)], 1u);
        const unsigned gen = old / nloc;
        if (old + 1u == (gen + 1u) * nloc) {
            __builtin_amdgcn_fence(__ATOMIC_RELEASE, "agent");
            asm volatile("s_waitcnt vmcnt(0)" ::: "memory");
            const unsigned og = xb_add(&bar[XB_TOP], 1u);
            const unsigned tg = og / nx;
            if (og + 1u == (tg + 1u) * nx) xb_add(&bar[XB_TOPGEN], 1u);
            else XB_SPIN(xb_ld(&bar[XB_TOPGEN]) == tg, bar);
            __builtin_amdgcn_fence(__ATOMIC_ACQUIRE, "agent");
            xb_add(&bar[XB_XGEN(b.x)], 1u);
            asm volatile("s_waitcnt vmcnt(0)" ::: "memory");
        } else {
            XB_SPIN(xb_ld(&bar[XB_XGEN(b.x)]) == gen, bar);
            __builtin_amdgcn_fence(__ATOMIC_ACQUIRE, "agent");
            asm volatile("s_waitcnt vmcnt(0)" ::: "memory");
        }
    }
    __syncthreads();
}

#define PH(...) do { if (MEGA || phase == idx) { unsigned char* const wsl = wsp(p); (void)wsl; __VA_ARGS__; } if (MEGA) { for (int _s = 0; _s < REP_SYNC; ++_s) { if (p.njobs < 0) grid.sync(); xcd_barrier(xb); } } ++idx; } while (0)
#define PHR(REP, ...) _Pragma("unroll 1") for (int rep = 0; rep < (REP); ++rep) { float* const xo = (rep == (REP) - 1) ? p.out : (float*)(p.ws + OFF_QN); (void)xo; PH(__VA_ARGS__); }
template <bool MEGA, int layer>
DI void run_layer(const Params& p, LAS unsigned char* lds, int& idx, const int phase, const XcdBarrier& xb, cg::grid_group& grid) {
    constexpr int kind = layer % 3, j = layer / 3;
        const float* gmix = p.norm_mix_g + layer * D;
    unsigned char* const wsl0 = wsp(p); (void)wsl0;
        if constexpr (kind == 0) {
            const void* xin = layer == 0 ? (const void*)p.x_in : (const void*)(wsl0 + OFF_XB);
            if constexpr (layer != 0) { PHR(REP_MISC, if (EN(1)) rstd_phase<true>(p, xin)); }
            PHR(REP_MISC, if (EN(2)) pool_phase<layer != 0>(p, xin, gmix));
            PHR(REP_GEMM, if (EN(3)) { MapPool mp{(const bf16_t*)(wsl + OFF_H), (const bf16_t*)(wsl + OFF_WPOOL) + (size_t)j * 4 * 512 * 512}; EpiRes<layer != 0, true> ep{xin, wsl + OFF_XB, p.pool_scale + j * D};
                 gemm_phase(lds, mp, ep, 64, 8, 512, 2048, 512); });
        } else if constexpr (kind == 1) {
            PHR(REP_MISC, if (EN(4)) norm_phase<true>(p, wsl + OFF_XB, gmix));
            PHR(REP_GEMM, if (EN(5)) { MapPlain mp{(const bf16_t*)(wsl + OFF_H), (const bf16_t*)(wsl + OFF_WQKV), 2048, 2048}; EpiBf16 ep{(bf16_t*)(wsl + OFF_QKV32), 2560, nullptr, 0, 1 << 30};
                 gemm_phase(lds, mp, ep, 64, 10, 2048, 2048, 2048); });
            PHR(REP_MISC, if (EN(6)) swa_prep_phase(p));
            PHR(REP_ATTN, if (EN(7)) swa_attn_phase(p, lds));
            PHR(REP_GEMM, if (EN(8)) { MapPlain mp{(const bf16_t*)(wsl + OFF_H), (const bf16_t*)(wsl + OFF_WSWAO), 2048, 2048}; EpiRes<true, true> ep{wsl + OFF_XB, wsl + OFF_XB, nullptr};
                 gemm_phase(lds, mp, ep, 64, 8, 2048, 2048, 2048); });
        } else {
            PHR(REP_MISC, if (EN(9)) norm_phase<true>(p, wsl + OFF_XB, gmix));
            PHR(REP_GEMM, if (EN(10)) { MapPlain mp{(const bf16_t*)(wsl + OFF_H), (const bf16_t*)(wsl + OFF_WDOWN), 2048, 2048}; EpiBf16 ep{(bf16_t*)(wsl + OFF_D32), 1280, nullptr, 0, 1 << 30};
                 gemm_phase(lds, mp, ep, 64, 5, 2048, 2048, 2048); });
            PHR(REP_MISC, if (EN(11)) mla_prep1_phase(p));
            PHR(REP_GEMM, if (EN(12)) { MapUqkv mp{(const bf16_t*)(wsl + OFF_CQ), (const bf16_t*)(wsl + OFF_CKV), (const bf16_t*)(wsl + OFF_WUQ), (const bf16_t*)(wsl + OFF_WUKV)};
                 EpiBf16 ep{(bf16_t*)(wsl + OFF_Q32), 3072, (bf16_t*)(wsl + OFF_KV32), 4096, 12};
                 gemm_phase(lds, mp, ep, 64, 28, 512, 512, 512); });
            PHR(REP_MISC, if (EN(13)) mla_prep2_phase(p));
            PHR(REP_ATTN, if (EN(14)) mla_attn_phase(p, lds));
            PHR(REP_GEMM, if (EN(15)) { MapPlain mp{(const bf16_t*)(wsl + OFF_H), (const bf16_t*)(wsl + OFF_WMLAO), 2048, 2048}; EpiRes<true, true> ep{wsl + OFF_XB, wsl + OFF_XB, nullptr};
                 gemm_phase(lds, mp, ep, 64, 8, 2048, 2048, 2048); });
        }
        PHR(REP_MISC, if (EN(16)) norm_phase<true>(p, wsl + OFF_XB, p.norm_ffn_g + layer * D));
        PHR(REP_GEMM, if (EN(17)) { MapPlain mp{(const bf16_t*)(wsl + OFF_H), (const bf16_t*)(wsl + OFF_WFIN) + (size_t)layer * 11264 * 2048, 2048, 2048};
             EpiGlu ep{p.ffn_conv_w + (size_t)layer * 3 * DFF, p.ffn_conv_b + (size_t)layer * DFF, (bf16_t*)(wsl + OFF_ACT), (float*)(wsl + OFF_EP), (float*)(wsl + OFF_ER), (float*)(wsl + OFF_EV)};
             gemm_phase(lds, mp, ep, 64, 44, 2048, 2048, 2048); });
        PHR(REP_MISC, if (EN(18)) glu_fix_phase(p, layer));
        PHR(REP_GEMM, if (EN(19)) { MapPlain mp{(const bf16_t*)(wsl + OFF_ACT), (const bf16_t*)(wsl + OFF_WFOUT) + (size_t)layer * 2048 * 5632, 5632, 5632}; EpiRes<true, layer != 3> ep{wsl + OFF_XB, layer == 3 ? (void*)p.out : (void*)(wsl + OFF_XB), nullptr};
             gemm_phase(lds, mp, ep, 64, 8, 5632, 5632, 5632); });
}

template <bool MEGA>
__global__ void __launch_bounds__(512) fwd_kernel(Params p, int phase) {
    extern __shared__ __attribute__((aligned(16))) unsigned char lds_raw[];
    LAS unsigned char* lds = (LAS unsigned char*)lds_raw;
    cg::grid_group grid = cg::this_grid();
    int idx = 0;
    volatile LAS unsigned* xst = (volatile LAS unsigned*)(lds + LDS_STAGE);
    if (threadIdx.x == 0) { xst[0] = 0u; xst[1] = 0u; xst[2] = 0u; xst[3] = 0u; }
    __syncthreads();
    const XcdBarrier xb = xcd_barrier_post((unsigned*)(p.ws + OFF_BAR), xst);
    PHR(REP_MISC, if (EN(0)) convert_phase(p, lds); rstd_phase<false>(p, p.x_in));
    run_layer<MEGA, 0>(p, lds, idx, phase, xb, grid);
    run_layer<MEGA, 1>(p, lds, idx, phase, xb, grid);
    run_layer<MEGA, 2>(p, lds, idx, phase, xb, grid);
    run_layer<MEGA, 3>(p, lds, idx, phase, xb, grid);
#undef PH
#undef PHR
}

__global__ void nan_fill(float* out, int n) { for (int i = blockIdx.x * blockDim.x + threadIdx.x; i < n; i += gridDim.x * blockDim.x) out[i] = __uint_as_float(0x7fc00000u); }

extern "C" void kernel_launch(void* const* d_in, const int* in_sizes, int n_in, void* d_out, int out_size, void* d_ws, size_t ws_size, hipStream_t stream) {
    if (ws_size < WS_END || n_in < 25) { fprintf(stderr, "kernel_launch: workspace too small (%zu < %zu) or bad n_in %d\n", ws_size, (size_t)WS_END, n_in);
        nan_fill<<<256, 256, 0, stream>>>((float*)d_out, out_size); return; }
    Params p{};
    p.x_in = (const float*)d_in[0]; p.positions = (const int*)d_in[1]; p.norm_mix_g = (const float*)d_in[2]; p.norm_ffn_g = (const float*)d_in[3];
    p.pool_scale = (const float*)d_in[5]; p.swa_q_gain = (const float*)d_in[7]; p.swa_k_gain = (const float*)d_in[8]; p.swa_sinks = (const float*)d_in[9];
    p.mla_q_a_gain = (const float*)d_in[12]; p.mla_kv_a_gain = (const float*)d_in[13]; p.mla_qn_gain = (const float*)d_in[16]; p.mla_qr_gain = (const float*)d_in[17];
    p.mla_kn_gain = (const float*)d_in[18]; p.mla_kr_gain = (const float*)d_in[19]; p.ffn_conv_w = (const float*)d_in[22]; p.ffn_conv_b = (const float*)d_in[23];
    p.out = (float*)d_out; p.ws = (unsigned char*)d_ws;
    unsigned char* ws = (unsigned char*)d_ws; int nj = 0;
    auto add = [&](const float* src, size_t off, int K, int N, int mode = 0) { p.jobs[nj].src = src; p.jobs[nj].dst = (bf16_t*)(ws + off); p.jobs[nj].K = K; p.jobs[nj].N = N; p.jobs[nj].mode = mode; ++nj; };
    for (int g = 0; g < 8; ++g) add((const float*)d_in[4] + (size_t)g * 512 * 512, OFF_WPOOL + (size_t)g * 512 * 512 * 2, 512, 512);
    add((const float*)d_in[6], OFF_WQKV, 2048, 2560);
    add((const float*)d_in[10], OFF_WSWAO, 2048, 2048);
    add((const float*)d_in[11], OFF_WDOWN, 2048, 1088);
    add((const float*)d_in[14], OFF_WUQ, 512, 3072);
    add((const float*)d_in[15], OFF_WUKV, 512, 4096);
    add((const float*)d_in[20], OFF_WMLAO, 2048, 2048);
    for (int i = 0; i < 4; ++i) add((const float*)d_in[21] + (size_t)i * 2048 * 11264, OFF_WFIN + (size_t)i * 11264 * 2048 * 2, 2048, 11264, 1);
    for (int i = 0; i < 4; ++i) add((const float*)d_in[24] + (size_t)i * 5632 * 2048, OFF_WFOUT + (size_t)i * 2048 * 5632 * 2, 5632, 2048);
    p.njobs = nj;
    static int grid_blocks = 0;
    if (!grid_blocks) {
        int dev = 0, cus = 0, per_cu = 0;
        (void)hipGetDevice(&dev); (void)hipDeviceGetAttribute(&cus, hipDeviceAttributeMultiprocessorCount, dev);
        (void)hipFuncSetAttribute((const void*)fwd_kernel<MEGA_MODE != 0>, hipFuncAttributeMaxDynamicSharedMemorySize, LDS_BYTES);
        (void)hipOccupancyMaxActiveBlocksPerMultiprocessor(&per_cu, (const void*)fwd_kernel<MEGA_MODE != 0>, 512, LDS_BYTES);
        if (per_cu < 1) per_cu = 1;
        if (per_cu > 1) per_cu = 1;
        if (cus < 1) cus = 256;
        grid_blocks = cus * per_cu; (void)hipGetLastError();
    }
    (void)hipMemsetAsync((unsigned char*)d_ws + OFF_BAR, 0, 16384, stream);
#if MEGA_MODE
    int ph = -1; void* args[] = {&p, &ph};
    hipError_t e = hipLaunchCooperativeKernel((const void*)fwd_kernel<true>, dim3(grid_blocks), dim3(512), args, LDS_BYTES, stream);
    if (e != hipSuccess) fprintf(stderr, "cooperative launch failed: %s (grid %d)\n", hipGetErrorString(e), grid_blocks);
#else
    for (int ph = 0; ph < NPHASES; ++ph) hipLaunchKernelGGL(fwd_kernel<false>, dim3(grid_blocks), dim3(512), LDS_BYTES, stream, p, ph);
#endif
}
```

```cpp
#include <hip/hip_runtime.h>
#include <hip/hip_cooperative_groups.h>
#include <cstdio>
namespace cg = cooperative_groups;

#ifndef MEGA_MODE
#define MEGA_MODE 1
#endif

#ifndef PHMASK
#define PHMASK 0xffffffffu
#endif
#define EN(k) ((PHMASK >> (k)) & 1u)
#ifndef REP_GEMM
#define REP_GEMM 1
#endif
#ifndef REP_ATTN
#define REP_ATTN 1
#endif
#ifndef REP_SYNC
#define REP_SYNC 1
#endif
#ifndef REP_MISC
#define REP_MISC 1
#endif
#define LAS __attribute__((address_space(3)))
#define DI __device__ __forceinline__
typedef unsigned short bf16_t;
typedef short bf16x8 __attribute__((ext_vector_type(8)));
typedef short s16x4 __attribute__((ext_vector_type(4)));
typedef float f32x2 __attribute__((ext_vector_type(2)));
typedef float f32x4 __attribute__((ext_vector_type(4)));
typedef float f32x16 __attribute__((ext_vector_type(16)));
typedef unsigned u32x2 __attribute__((ext_vector_type(2)));
typedef unsigned u32x4 __attribute__((ext_vector_type(4)));
typedef __bf16 hwbf16x2 __attribute__((ext_vector_type(2)));

constexpr int T = 16384, S = 4096, D = 2048, DFF = 5632;
constexpr float EPS = 1e-6f;
constexpr float LOG2E = 1.4426950408889634f;
constexpr int LDS_STAGE = 131072;
constexpr int LDS_BYTES = LDS_STAGE + 16;
constexpr int NPHASES = 34;

constexpr size_t OFF_WPOOL = 0;
constexpr size_t OFF_WQKV  = OFF_WPOOL + (size_t)2 * 4 * 512 * 512 * 2;
constexpr size_t OFF_WSWAO = OFF_WQKV + (size_t)2560 * 2048 * 2;
constexpr size_t OFF_WDOWN = OFF_WSWAO + (size_t)2048 * 2048 * 2;
constexpr size_t OFF_WUQ   = OFF_WDOWN + (size_t)1280 * 2048 * 2;
constexpr size_t OFF_WUKV  = OFF_WUQ + (size_t)3072 * 512 * 2;
constexpr size_t OFF_WMLAO = OFF_WUKV + (size_t)4096 * 512 * 2;
constexpr size_t OFF_WFIN  = OFF_WMLAO + (size_t)2048 * 2048 * 2;
constexpr size_t OFF_WFOUT = OFF_WFIN + (size_t)4 * 11264 * 2048 * 2;
constexpr size_t OFF_ROPE  = OFF_WFOUT + (size_t)4 * 2048 * 5632 * 2;
constexpr size_t OFF_RSTD  = OFF_ROPE + (size_t)S * 32 * 4 * 2;
constexpr size_t OFF_H     = OFF_RSTD + (size_t)T * 4;
constexpr size_t OFF_SCR   = OFF_H + (size_t)T * D * 2;
constexpr size_t OFF_U     = OFF_SCR;
constexpr size_t OFF_ACT   = OFF_U + (size_t)T * 11264 * 2;
constexpr size_t OFF_QKV32 = OFF_SCR;
constexpr size_t OFF_QS    = OFF_QKV32 + (size_t)T * 2560 * 4;
constexpr size_t OFF_KS    = OFF_QS + (size_t)T * 2048 * 2;
constexpr size_t OFF_VTS   = OFF_KS + (size_t)T * 256 * 2;
constexpr size_t OFF_D32   = OFF_SCR;
constexpr size_t OFF_CQ    = OFF_D32 + (size_t)T * 1280 * 4;
constexpr size_t OFF_CKV   = OFF_CQ + (size_t)T * 512 * 2;
constexpr size_t OFF_KPE   = OFF_CKV + (size_t)T * 512 * 2;
constexpr size_t OFF_Q32   = OFF_KPE + (size_t)T * 64 * 2;
constexpr size_t OFF_KV32  = OFF_Q32 + (size_t)T * 3072 * 4;
constexpr size_t OFF_QN    = OFF_KV32 + (size_t)T * 4096 * 4;
constexpr size_t OFF_KC    = OFF_QN + (size_t)T * 16 * 192 * 2;
constexpr size_t OFF_VT    = OFF_KC + (size_t)T * 16 * 192 * 2;
constexpr size_t OFF_BAR   = OFF_VT + (size_t)T * 2048 * 2;
constexpr size_t OFF_EP    = OFF_BAR + 16384;
constexpr size_t OFF_ER    = OFF_EP + (size_t)512 * DFF * 4;
constexpr size_t OFF_EV    = OFF_ER + (size_t)512 * DFF * 4;
constexpr size_t OFF_XB    = OFF_EV + (size_t)512 * DFF * 4;
constexpr size_t WS_END    = OFF_XB + (size_t)T * D * 2;

struct Job { const float* src; bf16_t* dst; int K, N, mode, pad; };
struct Params {
    const float* x_in; const int* positions; const float* norm_mix_g; const float* norm_ffn_g;
    const float* pool_scale; const float* swa_q_gain; const float* swa_k_gain; const float* swa_sinks;
    const float* mla_q_a_gain; const float* mla_kv_a_gain; const float* mla_qn_gain; const float* mla_qr_gain;
    const float* mla_kn_gain; const float* mla_kr_gain; const float* ffn_conv_w; const float* ffn_conv_b;
    float* out; unsigned char* ws;
    Job jobs[22]; int njobs; int pad;
};

DI unsigned char* wsp(const Params& p) { const unsigned long long a = (unsigned long long)p.ws; unsigned lo = __builtin_amdgcn_readfirstlane((unsigned)a), hi = __builtin_amdgcn_readfirstlane((unsigned)(a >> 32)); asm volatile("" : "+s"(lo), "+s"(hi)); return (unsigned char*)(((unsigned long long)hi << 32) | lo); }
#define WSP wsp(p)
DI unsigned pack2(float a, float b) { f32x2 v = {a, b}; hwbf16x2 r = __builtin_convertvector(v, hwbf16x2); return __builtin_bit_cast(unsigned, r); }
DI bf16_t f2bf(float a) { return (bf16_t)(pack2(a, 0.f) & 0xffffu); }
DI float bf2f(unsigned short b) { return __uint_as_float(((unsigned)b) << 16); }
DI float bflo(unsigned w) { return __uint_as_float(w << 16); }
DI float bfhi(unsigned w) { return __uint_as_float(w & 0xffff0000u); }
template <int CTRL> DI float dppf(float v) { return __builtin_bit_cast(float, __builtin_amdgcn_update_dpp(0, __builtin_bit_cast(int, v), CTRL, 0xf, 0xf, false)); }
DI float sum16(float v) { v += dppf<0x128>(v); v += dppf<0x124>(v); v += dppf<0x122>(v); v += dppf<0x121>(v); return v; }
DI f32x2 swap16(float v) { auto r = __builtin_amdgcn_permlane16_swap(__builtin_bit_cast(unsigned, v), __builtin_bit_cast(unsigned, v), false, false); return (f32x2){__builtin_bit_cast(float, r[0]), __builtin_bit_cast(float, r[1])}; }
DI f32x2 swap32(float v) { auto r = __builtin_amdgcn_permlane32_swap(__builtin_bit_cast(unsigned, v), __builtin_bit_cast(unsigned, v), false, false); return (f32x2){__builtin_bit_cast(float, r[0]), __builtin_bit_cast(float, r[1])}; }
DI float xsum32(float v) { return v + __shfl_xor(v, 32); }
DI float xmax32(float v) { return fmaxf(v, __shfl_xor(v, 32)); }
DI float wave_sum(float v) { for (int o = 32; o; o >>= 1) v += __shfl_xor(v, o); return v; }
DI float fast_exp2(float x) { return __builtin_amdgcn_exp2f(x); }
DI float dpp_ror1(float v)  { return __builtin_bit_cast(float, __builtin_amdgcn_update_dpp(0, __builtin_bit_cast(int, v), 0x121, 0xf, 0xf, false)); }
DI float dpp_ror15(float v) { return __builtin_bit_cast(float, __builtin_amdgcn_update_dpp(0, __builtin_bit_cast(int, v), 0x12F, 0xf, 0xf, false)); }
DI float silu_mul(float g, float v) { return g * v * __builtin_amdgcn_rcpf(1.0f + __builtin_amdgcn_exp2f(-LOG2E * g)); }
template <bool BF> DI f32x4 ldx4(const void* base, size_t e) {
    if constexpr (BF) { const u32x2 w = *(const u32x2*)((const bf16_t*)base + e); return (f32x4){__uint_as_float(w[0] << 16), __uint_as_float(w[0] & 0xffff0000u), __uint_as_float(w[1] << 16), __uint_as_float(w[1] & 0xffff0000u)}; }
    else return *(const f32x4*)((const float*)base + e);
}
DI int opaque_bid() { int b = blockIdx.x; asm volatile("" : "+s"(b)); return b; }
DI int opaque_tid() { int t = threadIdx.x; asm volatile("" : "+v"(t)); return t; }

DI void convert_phase(const Params& p, LAS unsigned char* lds) {
    unsigned char* const ws = wsp(p);
    const int bid = opaque_bid();
    LAS float* tile = (LAS float*)lds;
    const int tid = opaque_tid();
    for (int j = 0; j < p.njobs; ++j) {
        const float* src = p.jobs[j].src; bf16_t* dst = p.jobs[j].dst; const int K = p.jobs[j].K, N = p.jobs[j].N, mode = p.jobs[j].mode;
        const int nn = (N + 255) >> 8, ntile = (K >> 6) * nn;
        for (int ti = bid; ti < ntile; ti += gridDim.x) {
            const int tk = ti / nn, tn = ti - tk * nn;
            const int rr = tid >> 6, c4 = tid & 63, col = tn * 256 + c4 * 4;
            if (col < N) {
                f32x4 v[8];
#pragma unroll
                for (int i = 0; i < 8; ++i) v[i] = *(const f32x4*)(src + (size_t)(tk * 64 + rr + 8 * i) * N + col);
#pragma unroll
                for (int i = 0; i < 8; ++i) { LAS float* tp = tile + (rr + 8 * i) * 257 + c4 * 4; tp[0] = v[i][0]; tp[1] = v[i][1]; tp[2] = v[i][2]; tp[3] = v[i][3]; }
            }
            __syncthreads();
            const int k8 = (tid & 7) * 8;
#pragma unroll
            for (int r = 0; r < 4; ++r) {
                const int nl = (tid >> 3) + 64 * r, cbase = tn * 256 + 64 * r;
                if (cbase < N) {
                    u32x4 o;
#pragma unroll
                    for (int q = 0; q < 4; ++q) o[q] = pack2(tile[(k8 + 2 * q) * 257 + nl], tile[(k8 + 2 * q + 1) * 257 + nl]);
                    int orow = cbase;
                    if (mode) { const int hv = orow >= DFF, ch = orow - (hv ? DFF : 0); orow = (ch >> 7) * 256 + hv * 128 + (ch & 127); }
                    *(u32x4*)(dst + (size_t)(orow + (nl & 63)) * K + tk * 64 + k8) = o;
                }
            }
            __syncthreads();
        }
    }
    const int gtid = bid * 512 + tid, gsz = gridDim.x * 512;
    { u32x4* z = (u32x4*)(ws + OFF_WDOWN + (size_t)1088 * 2048 * 2); const int n16 = 192 * 2048 * 2 / 16;
      for (int i = gtid; i < n16; i += gsz) z[i] = (u32x4){0u, 0u, 0u, 0u}; }
    { float* ct = (float*)(ws + OFF_ROPE); float* st = ct + S * 32;
      for (int i = gtid; i < S * 32; i += gsz) { const int s = i >> 5, f = i & 31;
          const double inv = pow(10000.0, -(double)f / 32.0); const double a = (double)p.positions[s] * inv;
          ct[i] = (float)cos(a); st[i] = (float)sin(a); } }
}

template <bool BF> DI void rstd_phase(const Params& p, const void* x) {
    unsigned char* const ws = wsp(p);
    const int bid = opaque_bid();
    float* rstd = (float*)(ws + OFF_RSTD);
    const int tid = opaque_tid(), wid = tid >> 6, lane = tid & 63;
    for (int t = bid * 8 + wid; t < T; t += gridDim.x * 8) {
        float ss = 0.f;
#pragma unroll
        for (int i = 0; i < 8; ++i) { const f32x4 v = ldx4<BF>(x, (size_t)t * D + (i * 64 + lane) * 4); ss += v[0] * v[0] + v[1] * v[1] + v[2] * v[2] + v[3] * v[3]; }
        ss = wave_sum(ss);
        if (lane == 0) rstd[t] = rsqrtf(ss * (1.0f / D) + EPS);
    }
}

template <bool BF> DI void norm_phase(const Params& p, const void* x, const float* gain) {
    unsigned char* const ws = wsp(p);
    const int bid = opaque_bid();
    bf16_t* H = (bf16_t*)(ws + OFF_H);
    const int tid = opaque_tid(), wid = tid >> 6, lane = tid & 63;
    const int step = gridDim.x * 8;
    for (int t = bid * 8 + wid; t < T; t += 2 * step) {
        const int t2 = (t + step < T) ? t + step : t;
        f32x4 v[2][8];
#pragma unroll
        for (int q = 0; q < 2; ++q) {
            const int tt = q ? t2 : t;
#pragma unroll
            for (int i = 0; i < 4; ++i) {
                const size_t e = (size_t)tt * D + (i * 64 + lane) * 8;
                if constexpr (BF) { const u32x4 w = *(const u32x4*)((const bf16_t*)x + e);
                    v[q][2 * i] = (f32x4){bflo(w[0]), bfhi(w[0]), bflo(w[1]), bfhi(w[1])}; v[q][2 * i + 1] = (f32x4){bflo(w[2]), bfhi(w[2]), bflo(w[3]), bfhi(w[3])}; }
                else { v[q][2 * i] = *(const f32x4*)((const float*)x + e); v[q][2 * i + 1] = *(const f32x4*)((const float*)x + e + 4); }
            }
        }
        float ss[2] = {0.f, 0.f};
#pragma unroll
        for (int q = 0; q < 2; ++q)
#pragma unroll
            for (int i = 0; i < 8; ++i) ss[q] += v[q][i][0] * v[q][i][0] + v[q][i][1] * v[q][i][1] + v[q][i][2] * v[q][i][2] + v[q][i][3] * v[q][i][3];
        ss[0] = wave_sum(ss[0]); ss[1] = wave_sum(ss[1]);
#pragma unroll
        for (int q = 0; q < 2; ++q) {
            const int tt = q ? t2 : t;
            const float rs = rsqrtf(ss[q] * (1.0f / D) + EPS);
#pragma unroll
            for (int i = 0; i < 4; ++i) { const int c = (i * 64 + lane) * 8;
                const f32x4 g0 = *(const f32x4*)(gain + c), g1 = *(const f32x4*)(gain + c + 4);
                const f32x4 a = v[q][2 * i] * rs * g0, d = v[q][2 * i + 1] * rs * g1;
                u32x4 o; o[0] = pack2(a[0], a[1]); o[1] = pack2(a[2], a[3]); o[2] = pack2(d[0], d[1]); o[3] = pack2(d[2], d[3]);
                *(u32x4*)(H + (size_t)tt * D + c) = o; }
        }
    }
}

template <bool BF> DI void pool_phase(const Params& p, const void* x, const float* gain) {
    unsigned char* const ws = wsp(p);
    const int bid = opaque_bid();
    bf16_t* H = (bf16_t*)(ws + OFF_H); const float* rstd = (const float*)(ws + OFF_RSTD);
    const int tid = opaque_tid(), g = tid >> 7, left = 1 << g, right = (1 << g) - 1;
    const f32x4 gn = ((const f32x4*)gain)[tid];
    const int per = (T + gridDim.x - 1) / gridDim.x;
    if (gridDim.x == 256) {
        const int tb = bid * 64;
        f32x4 sm[4]; int pl[4], ph[4];
#pragma unroll
        for (int c = 0; c < 4; ++c) {
            const int t = tb + 16 * c, b = t / S, s = t - b * S;
            const int lo = max(s - left, 0), hi = min(s + right + 1, S);
            sm[c] = (f32x4){0.f, 0.f, 0.f, 0.f};
            for (int u = lo; u < hi; ++u) { const int tu = b * S + u; sm[c] += ldx4<BF>(x, (size_t)tu * D + tid * 4) * rstd[tu]; }
            pl[c] = lo; ph[c] = hi;
        }
        for (int i = 0; i < 16; ++i) {
            f32x4 va[4], vs[4], vm[4]; float ra[4], rs[4], rm[4], rc[4];
#pragma unroll
            for (int c = 0; c < 4; ++c) {
                const int t = tb + 16 * c + i, b = t / S, s = t - b * S;
                const int lo = max(s - left, 0), hi = min(s + right + 1, S);
                const int ta = b * S + hi - 1, ts = b * S + pl[c];
                va[c] = ldx4<BF>(x, (size_t)ta * D + tid * 4); vs[c] = ldx4<BF>(x, (size_t)ts * D + tid * 4); vm[c] = ldx4<BF>(x, (size_t)t * D + tid * 4);
                ra[c] = (i > 0 && hi > ph[c]) ? rstd[ta] : 0.f; rs[c] = (i > 0 && lo > pl[c]) ? rstd[ts] : 0.f; rm[c] = rstd[t];
                rc[c] = 1.0f / (float)(hi - lo); pl[c] = lo; ph[c] = hi;
            }
#pragma unroll
            for (int c = 0; c < 4; ++c) {
                const int t = tb + 16 * c + i;
                sm[c] += va[c] * ra[c] - vs[c] * rs[c];
                const f32x4 o = (sm[c] * rc[c] - vm[c] * rm[c]) * gn;
                u32x2 w; w[0] = pack2(o[0], o[1]); w[1] = pack2(o[2], o[3]);
                *(u32x2*)(H + (size_t)t * D + tid * 4) = w;
            }
        }
        return;
    }
    const int t0 = bid * per, t1 = min((bid + 1) * per, T);
    f32x4 sum = {0.f, 0.f, 0.f, 0.f}; int plo = 0, phi = 0;
    for (int t = t0; t < t1; ++t) {
        const int b = t / S, s = t - b * S;
        const int lo = max(s - left, 0), hi = min(s + right + 1, S);
        if (t == t0 || s == 0) {
            sum = (f32x4){0.f, 0.f, 0.f, 0.f};
            for (int u = lo; u < hi; ++u) { const int tu = b * S + u; const float r = rstd[tu]; const f32x4 v = ldx4<BF>(x, (size_t)tu * D + tid * 4); sum += v * r; }
        } else {
            if (hi > phi) { const int tu = b * S + hi - 1; sum += ldx4<BF>(x, (size_t)tu * D + tid * 4) * rstd[tu]; }
            if (lo > plo) { const int tu = b * S + plo;    sum -= ldx4<BF>(x, (size_t)tu * D + tid * 4) * rstd[tu]; }
        }
        plo = lo; phi = hi;
        const float rc = 1.0f / (float)(hi - lo);
        const f32x4 me = ldx4<BF>(x, (size_t)t * D + tid * 4) * rstd[t];
        const f32x4 o = (sum * rc - me) * gn;
        u32x2 w; w[0] = pack2(o[0], o[1]); w[1] = pack2(o[2], o[3]);
        *(u32x2*)(H + (size_t)t * D + tid * 4) = w;
    }
}

DI void glu_phase(const Params& p, int layer) {
    unsigned char* const ws = wsp(p);
    const int bid = opaque_bid();
    const bf16_t* U = (const bf16_t*)(ws + OFF_U); bf16_t* ACT = (bf16_t*)(ws + OFF_ACT);
    const float* cw = p.ffn_conv_w + (size_t)layer * 3 * DFF; const float* cb = p.ffn_conv_b + (size_t)layer * DFF;
    constexpr int NFG = DFF / 8, CH = 32, NTC = T / CH;
    const int tid = opaque_tid();
    for (int task = bid * 512 + tid; task < NFG * NTC; task += gridDim.x * 512) {
        const int tc = task / NFG, fg = task - tc * NFG, f0 = fg * 8, t0 = tc * CH;
        float w0[8], w1[8], w2[8], bb[8];
#pragma unroll
        for (int q = 0; q < 2; ++q) { const f32x4 a = *(const f32x4*)(cw + f0 + 4 * q), b = *(const f32x4*)(cw + DFF + f0 + 4 * q), c = *(const f32x4*)(cw + 2 * DFF + f0 + 4 * q), d = *(const f32x4*)(cb + f0 + 4 * q);
#pragma unroll
            for (int e = 0; e < 4; ++e) { w0[4 * q + e] = a[e]; w1[4 * q + e] = b[e]; w2[4 * q + e] = c[e]; bb[4 * q + e] = d[e]; } }
        const int s0 = t0 & (S - 1);
        u32x4 prev = {0u, 0u, 0u, 0u}, cur, nxt;
        if (s0 != 0) prev = *(const u32x4*)(U + (size_t)(t0 - 1) * 11264 + f0);
        cur = *(const u32x4*)(U + (size_t)t0 * 11264 + f0);
        for (int i = 0; i < CH; ++i) {
            const int t = t0 + i, s = s0 + i;
            nxt = (u32x4){0u, 0u, 0u, 0u};
            if (s != S - 1) nxt = *(const u32x4*)(U + (size_t)(t + 1) * 11264 + f0);
            const u32x4 vv = *(const u32x4*)(U + (size_t)t * 11264 + DFF + f0);
            u32x4 o;
#pragma unroll
            for (int q = 0; q < 4; ++q) {
                const float g0 = w0[2 * q] * bflo(prev[q]) + w1[2 * q] * bflo(cur[q]) + w2[2 * q] * bflo(nxt[q]) + bb[2 * q];
                const float g1 = w0[2 * q + 1] * bfhi(prev[q]) + w1[2 * q + 1] * bfhi(cur[q]) + w2[2 * q + 1] * bfhi(nxt[q]) + bb[2 * q + 1];
                const float a0 = g0 / (1.0f + __expf(-g0)) * bflo(vv[q]);
                const float a1 = g1 / (1.0f + __expf(-g1)) * bfhi(vv[q]);
                o[q] = pack2(a0, a1);
            }
            *(u32x4*)(ACT + (size_t)t * DFF + f0) = o;
            prev = cur; cur = nxt;
        }
    }
}

DI void glu_fix_phase(const Params& p, int layer) {
    unsigned char* const ws = wsp(p);
    const int bid = opaque_bid(), tid = opaque_tid();
    bf16_t* ACT = (bf16_t*)(ws + OFF_ACT);
    const float* EP = (const float*)(ws + OFF_EP); const float* ER = (const float*)(ws + OFF_ER); const float* EV = (const float*)(ws + OFF_EV);
    const float* cw = p.ffn_conv_w + (size_t)layer * 3 * DFF;
    constexpr int NC4 = DFF / 4;
    for (int task = bid * 512 + tid; task < 512 * NC4; task += gridDim.x * 512) {
        const int e = task / NC4, c = (task - e * NC4) * 4, b64 = e >> 1, last = e & 1, row = b64 * 64 + (last ? 63 : 0), sq = row & (S - 1);
        f32x4 gc = *(const f32x4*)(EP + (size_t)e * DFF + c);
        const f32x4 v = *(const f32x4*)(EV + (size_t)e * DFF + c);
        if (!last) { if (sq != 0) { const f32x4 nb = *(const f32x4*)(ER + (size_t)(e - 1) * DFF + c); gc += *(const f32x4*)(cw + c) * nb; } }
        else       { if (sq != S - 1) { const f32x4 nb = *(const f32x4*)(ER + (size_t)(e + 1) * DFF + c); gc += *(const f32x4*)(cw + 2 * DFF + c) * nb; } }
        u32x2 o;
        o[0] = pack2(gc[0] / (1.0f + __expf(-gc[0])) * v[0], gc[1] / (1.0f + __expf(-gc[1])) * v[1]);
        o[1] = pack2(gc[2] / (1.0f + __expf(-gc[2])) * v[2], gc[3] / (1.0f + __expf(-gc[3])) * v[3]);
        *(u32x2*)(ACT + (size_t)row * DFF + c) = o;
    }
}

DI void swa_prep_phase(const Params& p) {
    unsigned char* const ws = wsp(p);
    const int bid = opaque_bid();
    const bf16_t* QKV = (const bf16_t*)(ws + OFF_QKV32);
    bf16_t* QS = (bf16_t*)(ws + OFF_QS); bf16_t* KS = (bf16_t*)(ws + OFF_KS); bf16_t* VTS = (bf16_t*)(ws + OFF_VTS);
    const int tid = opaque_tid(), wid = tid >> 6, lane = tid & 63;
    const float qsc = 0.125f * LOG2E;
    const int tstep = gridDim.x * 8;
    for (int t0 = bid * 8 + wid; t0 < T; t0 += 2 * tstep)
      {
        u32x2 wl[2][9];
#pragma unroll
        for (int q2 = 0; q2 < 2; ++q2) { const int tq = t0 + q2 * tstep; if (tq < T) {
#pragma unroll
            for (int it = 0; it < 9; ++it) wl[q2][it] = *(const u32x2*)(QKV + (size_t)tq * 2560 + it * 256 + lane * 4); } }
#pragma unroll
      for (int q2 = 0; q2 < 2; ++q2) { const int t = t0 + q2 * tstep; if (t < T) {
        const int b = t / S, s = t - b * S;
#pragma unroll
        for (int it = 0; it < 9; ++it) {
            const int col = it * 256 + lane * 4;
            const u32x2 wv = wl[q2][it]; const f32x4 v = {bflo(wv[0]), bfhi(wv[0]), bflo(wv[1]), bfhi(wv[1])};
            float ss = v[0] * v[0] + v[1] * v[1] + v[2] * v[2] + v[3] * v[3];
            ss = sum16(ss);
            const float rs = rsqrtf(ss * (1.0f / 64.f) + EPS);
            const int d = col & 63;
            if (it < 8) { const f32x4 g = *(const f32x4*)(p.swa_q_gain + d); const float f = rs * qsc;
                u32x2 o; o[0] = pack2(v[0] * f * g[0], v[1] * f * g[1]); o[1] = pack2(v[2] * f * g[2], v[3] * f * g[3]);
                *(u32x2*)(QS + (size_t)t * 2048 + col) = o; }
            else { const f32x4 g = *(const f32x4*)(p.swa_k_gain + d); const int kvh = (col - 2048) >> 6;
                u32x2 o; o[0] = pack2(v[0] * rs * g[0], v[1] * rs * g[1]); o[1] = pack2(v[2] * rs * g[2], v[3] * rs * g[3]);
                *(u32x2*)(KS + ((size_t)(b * 4 + kvh) * S + s) * 64 + d) = o; }
        }
      } }
      }
    for (int ch = bid; ch < T / 64; ch += gridDim.x) {
        const int c = tid & 255, kvh = c >> 6, d = c & 63, tq = tid >> 8;
#pragma unroll
        for (int gi = 0; gi < 4; ++gi) {
            const int t0 = ch * 64 + (tq + 2 * gi) * 8, b = t0 / S, s0 = t0 - b * S;
            unsigned v[8];
#pragma unroll
            for (int e = 0; e < 8; ++e) v[e] = QKV[(size_t)(t0 + e) * 2560 + 2304 + c];
            u32x4 o; o[0] = v[0] | (v[1] << 16); o[1] = v[2] | (v[3] << 16); o[2] = v[4] | (v[5] << 16); o[3] = v[6] | (v[7] << 16);
            *(u32x4*)(VTS + ((size_t)(b * 4 + kvh) * 64 + d) * S + s0) = o;
        }
    }
}

template <int NDB, int VSTR>
DI void softmax_pv(const f32x16& sacc, float& m, float& l, f32x16 (&oacc)[NDB], LAS const unsigned char* vptr) {
    float mx = sacc[0];
#pragma unroll
    for (int i = 1; i < 16; ++i) mx = fmaxf(mx, sacc[i]);
    mx = xmax32(mx);
    if (__any(mx > m + 8.0f)) {
        const float mn = fmaxf(m, mx), alpha = fast_exp2(m - mn);
        l *= alpha; m = mn;
#pragma unroll
        for (int db = 0; db < NDB; ++db)
#pragma unroll
            for (int i = 0; i < 16; ++i) oacc[db][i] *= alpha;
    }
    float pv[16], ls = 0.f;
#pragma unroll
    for (int i = 0; i < 16; ++i) { pv[i] = fast_exp2(sacc[i] - m); ls += pv[i]; }
    l += ls;
#pragma unroll
    for (int s2 = 0; s2 < 2; ++s2) {
        u32x4 pw;
#pragma unroll
        for (int q = 0; q < 4; ++q) pw[q] = pack2(pv[8 * s2 + 2 * q], pv[8 * s2 + 2 * q + 1]);
        const bf16x8 pf = __builtin_bit_cast(bf16x8, pw);
#pragma unroll
        for (int db = 0; db < NDB; ++db) {
            const bf16x8 vf = *(LAS const bf16x8*)(vptr + db * 32 * VSTR + s2 * 32);
            oacc[db] = __builtin_amdgcn_mfma_f32_32x32x16_bf16(vf, pf, oacc[db], 0, 0, 0);
        }
    }
}

template <int NDB, int VSTR>
DI void load_vfrags(bf16x8 (&vf)[2][NDB], LAS const unsigned char* vptr) {
#pragma unroll
    for (int s2 = 0; s2 < 2; ++s2)
#pragma unroll
        for (int db = 0; db < NDB; ++db) {
            vf[s2][db] = *(LAS const bf16x8*)(vptr + db * 32 * VSTR + s2 * 32);
        }
}
template <int NDB>
DI void softmax_only(f32x16& sacc, float& m, float& l, f32x16 (&oacc)[NDB], bf16x8 (&pf)[2]) {
    float mx = sacc[0];
#pragma unroll
    for (int i = 1; i < 16; ++i) mx = fmaxf(mx, sacc[i]);
    mx = xmax32(mx);
    if (__any(mx > 8.0f)) {
        const float d = fmaxf(mx, 0.f), alpha = fast_exp2(-d);
        l *= alpha; m += d;
#pragma unroll
        for (int i = 0; i < 16; ++i) sacc[i] -= d;
#pragma unroll
        for (int db = 0; db < NDB; ++db)
#pragma unroll
            for (int i = 0; i < 16; ++i) oacc[db][i] *= alpha;
    }
    float pv[16], ls = 0.f;
#pragma unroll
    for (int i = 0; i < 16; ++i) { pv[i] = fast_exp2(sacc[i]); ls += pv[i]; }
    l += ls;
#pragma unroll
    for (int s2 = 0; s2 < 2; ++s2) {
        u32x4 pw;
#pragma unroll
        for (int q = 0; q < 4; ++q) pw[q] = pack2(pv[8 * s2 + 2 * q], pv[8 * s2 + 2 * q + 1]);
        pf[s2] = __builtin_bit_cast(bf16x8, pw);
    }
}

DI void swa_attn_phase(const Params& p, LAS unsigned char* lds) {
    unsigned char* const ws = wsp(p);
    const int bid = opaque_bid();
    constexpr int KSTR = 144, VSTR = 592, VOFF = 288 * KSTR;
    const bf16_t* QS = (const bf16_t*)(ws + OFF_QS); const bf16_t* KS = (const bf16_t*)(ws + OFF_KS); const bf16_t* VTS = (const bf16_t*)(ws + OFF_VTS);
    bf16_t* O = (bf16_t*)(ws + OFF_H);
    const int tid = opaque_tid(), wid = tid >> 6, lane = tid & 63, r = lane & 31, h = lane >> 5;
    for (int it0 = bid; it0 < 2048; it0 += gridDim.x) {
        const int item = (gridDim.x == 256) ? (((it0 >> 8) * 8 + (it0 & 7)) * 32 + ((it0 & 255) >> 3)) : it0;
        const int b = item >> 9, kvh = (item >> 7) & 3, qb = item & 127, q0 = qb * 32, kstart = q0 - 128;
        const bf16_t* Kg = KS + (size_t)(b * 4 + kvh) * S * 64; const bf16_t* Vg = VTS + (size_t)(b * 4 + kvh) * 64 * S;
        for (int c = tid; c < 2304; c += 512) { const int row = c >> 3, cc = c & 7, key = kstart + row;
            if (key >= 0 && key < S) *(LAS u32x4*)(lds + row * KSTR + cc * 16) = *(const u32x4*)(Kg + (size_t)key * 64 + cc * 8); }
        for (int c = tid; c < 2304; c += 512) { const int row = c / 36, cc = c - row * 36, key0 = kstart + cc * 8;
            if (key0 >= 0 && key0 < S) { const u32x4 v = *(const u32x4*)(Vg + (size_t)row * S + key0);
                LAS u32x2* dp = (LAS u32x2*)(lds + VOFF + row * VSTR + (cc >> 1) * 32 + (cc & 1) * 8); dp[0] = (u32x2){v[0], v[1]}; dp[2] = (u32x2){v[2], v[3]}; } }
        __syncthreads();
        const int hq = kvh * 8 + wid;
        const float slope2 = exp2f(-(float)(hq + 1) * 0.25f) * LOG2E, sink2 = p.swa_sinks[hq] * LOG2E;
        const bf16_t* Qp = QS + (size_t)(b * S + q0 + r) * 2048 + hq * 64 + 8 * h;
        bf16x8 qf[4];
#pragma unroll
        for (int ks = 0; ks < 4; ++ks) qf[ks] = *(const bf16x8*)(Qp + 16 * ks);
        const int qi = q0 + r, pq = p.positions[qi];
        float m = sink2, l = 0.f;
        f32x16 oacc[2];
#pragma unroll
        for (int db = 0; db < 2; ++db)
#pragma unroll
            for (int i = 0; i < 16; ++i) oacc[db][i] = 0.f;
        for (int blk = 0; blk < 9; ++blk) {
            const int k0 = kstart + blk * 32;
            if (k0 < 0 || k0 >= S) continue;
            f32x16 sacc;
#pragma unroll
            for (int i = 0; i < 16; ++i) sacc[i] = 0.f;
#pragma unroll
            for (int ks = 0; ks < 4; ++ks) { const bf16x8 a = *(LAS const bf16x8*)(lds + (blk * 32 + r) * KSTR + ks * 32 + h * 16);
                sacc = __builtin_amdgcn_mfma_f32_32x32x16_bf16(a, qf[ks], sacc, 0, 0, 0); }
#pragma unroll
            for (int i = 0; i < 16; ++i) { const int key = k0 + (i & 3) + 8 * (i >> 2) + 4 * h;
                const int dk = qi - key, dp = pq - p.positions[key];
                const float sv = sacc[i] - slope2 * (float)(dp < 0 ? -dp : dp);
                sacc[i] = ((dk < 0 ? -dk : dk) <= 128) ? sv : -INFINITY; }
            softmax_pv<2, VSTR>(sacc, m, l, oacc, lds + VOFF + r * VSTR + blk * 64 + h * 16);
        }
        const float lt = xsum32(l) + fast_exp2(sink2 - m), inv = 1.0f / lt;
        bf16_t* Op = O + (size_t)(b * S + qi) * 2048 + hq * 64 + 4 * h;
#pragma unroll
        for (int db = 0; db < 2; ++db)
#pragma unroll
            for (int g = 0; g < 4; ++g) { u32x2 o; o[0] = pack2(oacc[db][4 * g] * inv, oacc[db][4 * g + 1] * inv); o[1] = pack2(oacc[db][4 * g + 2] * inv, oacc[db][4 * g + 3] * inv);
                *(u32x2*)(Op + db * 32 + 8 * g) = o; }
        __syncthreads();
    }
}

DI void mla_prep1_phase(const Params& p) {
    unsigned char* const ws = wsp(p);
    const int bid = opaque_bid();
    const bf16_t* D32 = (const bf16_t*)(ws + OFF_D32);
    bf16_t* CQ = (bf16_t*)(ws + OFF_CQ); bf16_t* CKV = (bf16_t*)(ws + OFF_CKV); bf16_t* KPE = (bf16_t*)(ws + OFF_KPE);
    const float* ct = (const float*)(ws + OFF_ROPE); const float* st = ct + S * 32;
    const int tid = opaque_tid(), wid = tid >> 6, lane = tid & 63;
    const int tstep = gridDim.x * 8;
    for (int t0 = bid * 8 + wid; t0 < T; t0 += 2 * tstep)
      {
        u32x2 wl[2][4]; unsigned short kx[2];
#pragma unroll
        for (int q2 = 0; q2 < 2; ++q2) { const int tq = t0 + q2 * tstep; if (tq < T) { const bf16_t* rw = D32 + (size_t)tq * 1280;
#pragma unroll
            for (int part = 0; part < 2; ++part) { wl[q2][2 * part] = *(const u32x2*)(rw + part * 512 + lane * 4); wl[q2][2 * part + 1] = *(const u32x2*)(rw + part * 512 + 256 + lane * 4); }
            kx[q2] = rw[1024 + lane]; } }
#pragma unroll
      for (int q2 = 0; q2 < 2; ++q2) { const int t = t0 + q2 * tstep; if (t < T) {
        const int s = t & (S - 1);
#pragma unroll
        for (int part = 0; part < 2; ++part) {
            const u32x2 wa = wl[q2][2 * part], wc2 = wl[q2][2 * part + 1];
            const f32x4 a = {bflo(wa[0]), bfhi(wa[0]), bflo(wa[1]), bfhi(wa[1])}, c = {bflo(wc2[0]), bfhi(wc2[0]), bflo(wc2[1]), bfhi(wc2[1])};
            float ss = a[0] * a[0] + a[1] * a[1] + a[2] * a[2] + a[3] * a[3] + c[0] * c[0] + c[1] * c[1] + c[2] * c[2] + c[3] * c[3];
            ss = wave_sum(ss);
            const float rs = rsqrtf(ss * (1.0f / 512.f) + EPS);
            const float* gp = part ? p.mla_kv_a_gain : p.mla_q_a_gain; bf16_t* dst = (part ? CKV : CQ) + (size_t)t * 512;
            const f32x4 g0 = *(const f32x4*)(gp + lane * 4), g1 = *(const f32x4*)(gp + 256 + lane * 4);
            u32x2 o0, o1; o0[0] = pack2(a[0] * rs * g0[0], a[1] * rs * g0[1]); o0[1] = pack2(a[2] * rs * g0[2], a[3] * rs * g0[3]);
            o1[0] = pack2(c[0] * rs * g1[0], c[1] * rs * g1[1]); o1[1] = pack2(c[2] * rs * g1[2], c[3] * rs * g1[3]);
            *(u32x2*)(dst + lane * 4) = o0; *(u32x2*)(dst + 256 + lane * 4) = o1;
        }
        const float x = bf2f(kx[q2]);
        const float ss = wave_sum(x * x);
        const float xn = x * rsqrtf(ss * (1.0f / 64.f) + EPS) * p.mla_kr_gain[lane];
        const float pr = __shfl_xor(xn, 32);
        const float cc = ct[s * 32 + (lane & 31)], sn = st[s * 32 + (lane & 31)];
        const float o = lane < 32 ? xn * cc - pr * sn : xn * cc + pr * sn;
        KPE[(size_t)t * 64 + lane] = f2bf(o);
      } }
      }
}

DI void mla_prep2_phase(const Params& p) {
    unsigned char* const ws = wsp(p);
    const int bid = opaque_bid();
    const bf16_t* Q32 = (const bf16_t*)(ws + OFF_Q32); const bf16_t* KV32 = (const bf16_t*)(ws + OFF_KV32); const bf16_t* KPE = (const bf16_t*)(ws + OFF_KPE);
    bf16_t* QN = (bf16_t*)(ws + OFF_QN); bf16_t* KC = (bf16_t*)(ws + OFF_KC); bf16_t* VT = (bf16_t*)(ws + OFF_VT);
    const float* ct = (const float*)(ws + OFF_ROPE); const float* st = ct + S * 32;
    const int tid = opaque_tid(), wid = tid >> 6, lane = tid & 63;
    const float qsc = 0.07216878364870322f * LOG2E;
    const int j = lane & 15, hsub = lane >> 4;
    float gqn[8], gkn[8], gqr[4];
#pragma unroll
    for (int e = 0; e < 8; ++e) { gqn[e] = p.mla_qn_gain[8 * j + e]; gkn[e] = p.mla_kn_gain[8 * j + e]; }
#pragma unroll
    for (int e = 0; e < 4; ++e) gqr[e] = p.mla_qr_gain[4 * j + e];
    const int tstride = gridDim.x * 8;
    for (int task0 = bid * 8 + wid; task0 < T * 4; task0 += 4 * tstride) {
        u32x4 wq4[4], wk4[4]; u32x2 wp4[4], kp4[4];
#pragma unroll
        for (int u = 0; u < 4; ++u) {
            const int task = task0 + u * tstride;
            if (task < T * 4) {
                const int t = task >> 2, hh = (task & 3) * 4 + hsub;
                const bf16_t* qrow = Q32 + (size_t)t * 3072 + hh * 192; const bf16_t* kvrow = KV32 + (size_t)t * 4096 + hh * 256;
                wq4[u] = *(const u32x4*)(qrow + 8 * j); wk4[u] = *(const u32x4*)(kvrow + 8 * j);
                wp4[u] = *(const u32x2*)(qrow + 128 + 4 * j); kp4[u] = *(const u32x2*)(KPE + (size_t)t * 64 + 4 * j);
            }
        }
#pragma unroll
        for (int u = 0; u < 4; ++u) {
            const int task = task0 + u * tstride;
            if (task < T * 4) {
                const int t = task >> 2, hh = (task & 3) * 4 + hsub, b = t / S, s = t - b * S;
                const size_t ob = ((size_t)(b * 16 + hh) * S + s) * 192;
                const u32x4 wq = wq4[u], wk = wk4[u]; const u32x2 wp = wp4[u], kp = kp4[u];
                float q[8], k[8], x[4];
#pragma unroll
                for (int e = 0; e < 4; ++e) { q[2 * e] = bflo(wq[e]); q[2 * e + 1] = bfhi(wq[e]); k[2 * e] = bflo(wk[e]); k[2 * e + 1] = bfhi(wk[e]); }
                x[0] = bflo(wp[0]); x[1] = bfhi(wp[0]); x[2] = bflo(wp[1]); x[3] = bfhi(wp[1]);
                float sq = 0.f, sk = 0.f, sx = 0.f;
#pragma unroll
                for (int e = 0; e < 8; ++e) { sq += q[e] * q[e]; sk += k[e] * k[e]; }
#pragma unroll
                for (int e = 0; e < 4; ++e) sx += x[e] * x[e];
                sq = sum16(sq); sk = sum16(sk); sx = sum16(sx);
                const float fq = rsqrtf(sq * (1.0f / 128.f) + EPS) * qsc, fk = rsqrtf(sk * (1.0f / 128.f) + EPS), fx = rsqrtf(sx * (1.0f / 64.f) + EPS);
                u32x4 oq, ok;
#pragma unroll
                for (int e = 0; e < 4; ++e) { oq[e] = pack2(q[2 * e] * fq * gqn[2 * e], q[2 * e + 1] * fq * gqn[2 * e + 1]); ok[e] = pack2(k[2 * e] * fk * gkn[2 * e], k[2 * e + 1] * fk * gkn[2 * e + 1]); }
                *(u32x4*)(QN + ob + 8 * j) = oq; *(u32x4*)(KC + ob + 8 * j) = ok;
                float ro[4];
#pragma unroll
                for (int e = 0; e < 4; ++e) { const float xn = x[e] * fx * gqr[e], pr = dppf<0x128>(xn);
                    const int fi = (4 * j + e) & 31; const float cc = ct[s * 32 + fi], sn = st[s * 32 + fi];
                    ro[e] = (j < 8 ? xn * cc - pr * sn : xn * cc + pr * sn) * qsc; }
                u32x2 op; op[0] = pack2(ro[0], ro[1]); op[1] = pack2(ro[2], ro[3]);
                *(u32x2*)(QN + ob + 128 + 4 * j) = op;
                *(u32x2*)(KC + ob + 128 + 4 * j) = kp;
            }
        }
    }
    for (int bt = bid; bt < (T / 64) * 16; bt += gridDim.x) {
        const int ch = bt >> 4, hh = bt & 15, dv = tid & 127, tq = tid >> 7;
#pragma unroll
        for (int gi = 0; gi < 2; ++gi) {
            const int t0 = ch * 64 + (tq + 4 * gi) * 8, b = t0 / S, s0 = t0 - b * S;
            unsigned v[8];
#pragma unroll
            for (int e = 0; e < 8; ++e) v[e] = KV32[(size_t)(t0 + e) * 4096 + hh * 256 + 128 + dv];
            u32x4 o; o[0] = v[0] | (v[1] << 16); o[1] = v[2] | (v[3] << 16); o[2] = v[4] | (v[5] << 16); o[3] = v[6] | (v[7] << 16);
            *(u32x4*)(VT + ((size_t)(b * 16 + hh) * 128 + dv) * S + s0) = o;
        }
    }
}

DI void mla_attn_phase(const Params& p, LAS unsigned char* lds) {
    unsigned char* const ws = wsp(p);
    const int bid = opaque_bid();
    constexpr int KSTR = 400, VSTR = 144, KBUF = 64 * KSTR, VBUF = 128 * VSTR, BUF = KBUF + VBUF, NT = S / 64;
    const bf16_t* QN = (const bf16_t*)(ws + OFF_QN); const bf16_t* KC = (const bf16_t*)(ws + OFF_KC); const bf16_t* VT = (const bf16_t*)(ws + OFF_VT);
    bf16_t* O = (bf16_t*)(ws + OFF_H);
    const int tid = opaque_tid(), wid = tid >> 6, lane = tid & 63, r = lane & 31, h = lane >> 5;
    unsigned klds[3], vlds[2], vgo[2];
#pragma unroll
    for (int i = 0; i < 3; ++i) { const int c = tid + 512 * i, kr = c / 24; klds[i] = (unsigned)(kr * KSTR + (c - kr * 24) * 16); }
#pragma unroll
    for (int i = 0; i < 2; ++i) { const int c = tid + 512 * i, vr = c >> 3, vc = c & 7; vlds[i] = (unsigned)(KBUF + vr * VSTR + (vc >> 1) * 32 + (vc & 1) * 8); vgo[i] = (unsigned)((vr * S + vc * 8) * 2); }
    const unsigned kgo = (unsigned)tid * 16u;
    for (int it0 = bid; it0 < 1024; it0 += gridDim.x) {
        const int item = (gridDim.x == 256) ? (((it0 >> 8) * 8 + (it0 & 7)) * 32 + ((it0 & 255) >> 3)) : it0;
        const int bh = item >> 4, qb = item & 15, b = bh >> 4, hh = bh & 15, q0 = qb * 256 + wid * 32;
        const char* Kg = (const char*)(KC + (size_t)bh * S * 192); const char* Vg = (const char*)(VT + (size_t)bh * 128 * S);
        const bf16_t* Qp = QN + ((size_t)bh * S + q0 + r) * 192 + 8 * h;
        bf16x8 qf[12];
#pragma unroll
        for (int ks = 0; ks < 12; ++ks) qf[ks] = *(const bf16x8*)(Qp + 16 * ks);
        u32x4 kreg[3], vreg[2];
#define MLA_LOAD(k0) do { const char* kt_ = Kg + (size_t)(k0) * 384; const char* vt_ = Vg + (size_t)(k0) * 2; \
                          _Pragma("unroll") for (int i = 0; i < 3; ++i) kreg[i] = *(const u32x4*)(kt_ + kgo + i * 8192); \
                          _Pragma("unroll") for (int i = 0; i < 2; ++i) vreg[i] = *(const u32x4*)(vt_ + vgo[i]); } while (0)
#define MLA_STORE(bufp) do { _Pragma("unroll") for (int i = 0; i < 3; ++i) *(LAS u32x4*)((bufp) + klds[i]) = kreg[i]; \
                             _Pragma("unroll") for (int i = 0; i < 2; ++i) { LAS u32x2* dp = (LAS u32x2*)((bufp) + vlds[i]); \
                                 dp[0] = (u32x2){vreg[i][0], vreg[i][1]}; dp[2] = (u32x2){vreg[i][2], vreg[i][3]}; } } while (0)
        MLA_LOAD(0); MLA_STORE(lds);
        __syncthreads();
        float m = 0.f, l = 0.f;
        f32x16 oacc[4];
#pragma unroll
        for (int db = 0; db < 4; ++db)
#pragma unroll
            for (int i = 0; i < 16; ++i) oacc[db][i] = 0.f;
        for (int t = 0; t < NT; ++t) {
            if (t + 1 < NT) MLA_LOAD((t + 1) * 64);
            LAS unsigned char* kb = lds + (t & 1) * BUF;
#pragma unroll
            for (int blk = 0; blk < 2; ++blk) {
                bf16x8 kf[12];
                LAS const unsigned char* kp = kb + (blk * 32 + r) * KSTR + h * 16;
#pragma unroll
                for (int ks = 0; ks < 4; ++ks) kf[ks] = *(LAS const bf16x8*)(kp + ks * 32);
                f32x16 sacc;
#pragma unroll
                for (int i = 0; i < 16; ++i) sacc[i] = -m;
#pragma unroll
                for (int kg = 0; kg < 3; ++kg) {
                    if (kg < 2) {
#pragma unroll
                        for (int ks = 0; ks < 4; ++ks) kf[4 * (kg + 1) + ks] = *(LAS const bf16x8*)(kp + (4 * (kg + 1) + ks) * 32);
                    }
#pragma unroll
                    for (int ks = 0; ks < 4; ++ks) sacc = __builtin_amdgcn_mfma_f32_32x32x16_bf16(kf[4 * kg + ks], qf[4 * kg + ks], sacc, 0, 0, 0);
                }
                bf16x8 vf[2][4], pf[2];
                load_vfrags<4, VSTR>(vf, kb + KBUF + r * VSTR + blk * 64 + h * 16);
                softmax_only<4>(sacc, m, l, oacc, pf);
#pragma unroll
                for (int s2 = 0; s2 < 2; ++s2)
#pragma unroll
                    for (int db = 0; db < 4; ++db) oacc[db] = __builtin_amdgcn_mfma_f32_32x32x16_bf16(vf[s2][db], pf[s2], oacc[db], 0, 0, 0);
            }
            if (t + 1 < NT) MLA_STORE(lds + ((t + 1) & 1) * BUF);
            __syncthreads();
        }
#undef MLA_LOAD
#undef MLA_STORE
        const float lt = xsum32(l), inv = 1.0f / lt;
        bf16_t* Op = O + (size_t)(b * S + q0 + r) * 2048 + hh * 128 + 4 * h;
#pragma unroll
        for (int db = 0; db < 4; ++db)
#pragma unroll
            for (int g = 0; g < 4; ++g) { u32x2 o; o[0] = pack2(oacc[db][4 * g] * inv, oacc[db][4 * g + 1] * inv); o[1] = pack2(oacc[db][4 * g + 2] * inv, oacc[db][4 * g + 3] * inv);
                *(u32x2*)(Op + db * 32 + 8 * g) = o; }
    }
}

constexpr int BM = 256, BK = 64, HALF = 128, HTB = HALF * BK * 2, NXCD = 8, WGM = 8;
DI int lds_byte(int r, int c) { const int st = (r >> 4) * 2 + (c >> 5), rr = r & 15, cc = c & 31, ob = rr * 64 + cc * 2; return st * 1024 + (ob ^ (((ob >> 9) & 1) << 5)); }
DI int perm32(int rho) { const int n = rho >> 4, i = rho & 15; return 8 * (i >> 2) + 4 * n + (i & 3); }
DI void stage_rc(int b, int& R, int& C) { const int st = b / 1024, sb = b % 1024, swz = sb ^ (((sb >> 9) & 1) << 5); R = (st >> 1) * 16 + swz / 64; C = (st & 1) * 32 + (swz % 64) / 2; }
struct Unit { int pm, pn; };
DI bool sched_next(int i, int nM, int nN, int G, int c, Unit& u) {
    const int nwg = nM * nN; const long L = (long)i * G + c; if (L >= nwg) return false;
    int wgid = (int)L; { const int q = nwg / NXCD, r = nwg % NXCD, xcd = wgid % NXCD, off = wgid / NXCD; wgid = (xcd < r ? xcd * (q + 1) : r * (q + 1) + (xcd - r) * q) + off; }
    const int nig = WGM * nN, gid = wgid / nig, fm = gid * WGM, gsz = (nM - fm) < WGM ? (nM - fm) : WGM;
    u.pm = fm + ((wgid % nig) % gsz); u.pn = (wgid % nig) / gsz; return true;
}

struct EpiF32 {
    static constexpr bool PERM = false;
    float* C; int ldc; float* C2; int ldc2; int split;
    DI void operator()(const f32x4 (&acc)[2][2][4][2], const Unit& u, int wr, int wc, int fr, int fq) const {
        float* base = C; int ld = ldc, pn = u.pn; if (pn >= split) { base = C2; ld = ldc2; pn -= split; }
        const int row0 = u.pm * BM + wr * 64 + fr, col0 = pn * BM + wc * 32 + 4 * fq;
#pragma unroll
        for (int ai = 0; ai < 2; ++ai)
#pragma unroll
            for (int m = 0; m < 4; ++m) { float* rowp = base + (size_t)(row0 + ai * HALF + m * 16) * ld + col0;
#pragma unroll
                for (int bj = 0; bj < 2; ++bj)
#pragma unroll
                    for (int n = 0; n < 2; ++n) *(f32x4*)(rowp + bj * HALF + n * 16) = acc[ai][bj][m][n]; }
    }
};
struct EpiBf16 {
    static constexpr bool PERM = true;
    bf16_t* O1; int ldc1; bf16_t* O2; int ldc2; int split;
    DI void operator()(const f32x4 (&acc)[2][2][4][2], const Unit& u, int wr, int wc, int fr, int fq) const {
        bf16_t* O = O1; int ldc = ldc1, pn = u.pn; if (pn >= split) { O = O2; ldc = ldc2; pn -= split; }
        const int row0 = u.pm * BM + wr * 64 + fr, col0 = pn * BM + wc * 32 + 8 * fq;
#pragma unroll
        for (int ai = 0; ai < 2; ++ai)
#pragma unroll
            for (int m = 0; m < 4; ++m) { bf16_t* rowp = O + (size_t)(row0 + ai * HALF + m * 16) * ldc + col0;
#pragma unroll
                for (int bj = 0; bj < 2; ++bj) { const f32x4 v0 = acc[ai][bj][m][0], v1 = acc[ai][bj][m][1];
                    u32x4 o; o[0] = pack2(v0[0], v0[1]); o[1] = pack2(v0[2], v0[3]); o[2] = pack2(v1[0], v1[1]); o[3] = pack2(v1[2], v1[3]);
                    *(u32x4*)(rowp + bj * HALF) = o; } }
    }
};
template <bool IB, bool OB> struct EpiRes {
    static constexpr bool PERM = true;
    const void* Xin; void* Xout; const float* scale;
    DI void operator()(const f32x4 (&acc)[2][2][4][2], const Unit& u, int wr, int wc, int fr, int fq) const {
        const int row0 = u.pm * BM + wr * 64 + fr, col0 = u.pn * BM + wc * 32 + 8 * fq;
        f32x4 sc[2][2];
#pragma unroll
        for (int bj = 0; bj < 2; ++bj)
#pragma unroll
            for (int n = 0; n < 2; ++n) sc[bj][n] = scale ? *(const f32x4*)(scale + col0 + bj * HALF + 4 * n) : (f32x4){1.f, 1.f, 1.f, 1.f};
#pragma unroll
        for (int ai = 0; ai < 2; ++ai)
#pragma unroll
            for (int m = 0; m < 4; ++m) { const size_t ro = (size_t)(row0 + ai * HALF + m * 16) * D + col0;
#pragma unroll
                for (int bj = 0; bj < 2; ++bj) {
                    f32x4 x0, x1;
                    if constexpr (IB) { const u32x4 w = *(const u32x4*)((const bf16_t*)Xin + ro + bj * HALF);
                        x0 = (f32x4){bflo(w[0]), bfhi(w[0]), bflo(w[1]), bfhi(w[1])}; x1 = (f32x4){bflo(w[2]), bfhi(w[2]), bflo(w[3]), bfhi(w[3])}; }
                    else { x0 = *(const f32x4*)((const float*)Xin + ro + bj * HALF); x1 = *(const f32x4*)((const float*)Xin + ro + bj * HALF + 4); }
                    x0 += acc[ai][bj][m][0] * sc[bj][0]; x1 += acc[ai][bj][m][1] * sc[bj][1];
                    if constexpr (OB) { u32x4 o; o[0] = pack2(x0[0], x0[1]); o[1] = pack2(x0[2], x0[3]); o[2] = pack2(x1[0], x1[1]); o[3] = pack2(x1[2], x1[3]);
                        *(u32x4*)((bf16_t*)Xout + ro + bj * HALF) = o; }
                    else { *(f32x4*)((float*)Xout + ro + bj * HALF) = x0; *(f32x4*)((float*)Xout + ro + bj * HALF + 4) = x1; } } }
    }
};
struct EpiGlu {
    static constexpr bool PERM = true;
    const float* cw; const float* cb; bf16_t* ACT; float* EP; float* ER; float* EV;
    DI void operator()(const f32x4 (&acc)[2][2][4][2], const Unit& u, int wr, int wc, int fr, int fq) const {
        const int row0 = u.pm * BM + wr * 64 + fr, ch0 = u.pn * 128 + wc * 32 + 8 * fq;
        f32x4 w0[2], w1[2], w2[2], bb[2];
#pragma unroll
        for (int n = 0; n < 2; ++n) { w0[n] = *(const f32x4*)(cw + ch0 + 4 * n); w1[n] = *(const f32x4*)(cw + DFF + ch0 + 4 * n); w2[n] = *(const f32x4*)(cw + 2 * DFF + ch0 + 4 * n); bb[n] = *(const f32x4*)(cb + ch0 + 4 * n); }
#pragma unroll
        for (int ai = 0; ai < 2; ++ai)
#pragma unroll
            for (int m = 0; m < 4; ++m) {
                const bool efirst = (m == 0) && (fr == 0), elast = (m == 3) && (fr == 15);
                const int row = row0 + ai * HALF + m * 16;
                f32x4 gc[2];
#pragma unroll
                for (int n = 0; n < 2; ++n) {
                    const f32x4 g = acc[ai][0][m][n];
                    const f32x4 gprev = acc[ai][0][m > 0 ? m - 1 : 0][n], gnext = acc[ai][0][m < 3 ? m + 1 : 3][n];
                    f32x4 up, dn;
#pragma unroll
                    for (int e = 0; e < 4; ++e) {
                        const float pu = (m > 0 && fr == 15) ? gprev[e] : g[e];
                        const float pd = (m < 3 && fr == 0) ? gnext[e] : g[e];
                        up[e] = dpp_ror1(pu); dn[e] = dpp_ror15(pd);
                    }
                    if (efirst) up = (f32x4){0.f, 0.f, 0.f, 0.f};
                    if (elast) dn = (f32x4){0.f, 0.f, 0.f, 0.f};
                    gc[n] = w0[n] * up + w1[n] * g + w2[n] * dn + bb[n];
                }
                if (efirst || elast) {
                    const size_t eo = (size_t)((row >> 6) * 2 + (elast ? 1 : 0)) * DFF + ch0;
#pragma unroll
                    for (int n = 0; n < 2; ++n) { *(f32x4*)(EP + eo + 4 * n) = gc[n]; *(f32x4*)(ER + eo + 4 * n) = acc[ai][0][m][n]; *(f32x4*)(EV + eo + 4 * n) = acc[ai][1][m][n]; }
                } else {
                    const f32x4 v0 = acc[ai][1][m][0], v1 = acc[ai][1][m][1];
                    u32x4 o;
                    o[0] = pack2(silu_mul(gc[0][0], v0[0]), silu_mul(gc[0][1], v0[1])); o[1] = pack2(silu_mul(gc[0][2], v0[2]), silu_mul(gc[0][3], v0[3]));
                    o[2] = pack2(silu_mul(gc[1][0], v1[0]), silu_mul(gc[1][1], v1[1])); o[3] = pack2(silu_mul(gc[1][2], v1[2]), silu_mul(gc[1][3], v1[3]));
                    *(u32x4*)(ACT + (size_t)row * DFF + ch0) = o;
                }
            }
    }
};
struct MapPlain { const bf16_t* A; const bf16_t* B; int lda, ldb;
    DI const char* a(const Unit& u) const { return (const char*)(A + (size_t)u.pm * BM * lda); }
    DI const char* b(const Unit& u) const { return (const char*)(B + (size_t)u.pn * BM * ldb); } };
struct MapPool { const bf16_t* A; const bf16_t* B;
    DI const char* a(const Unit& u) const { return (const char*)(A + (size_t)u.pm * BM * 2048 + (u.pn >> 1) * 512); }
    DI const char* b(const Unit& u) const { return (const char*)(B + ((size_t)(u.pn >> 1) * 512 + (u.pn & 1) * 256) * 512); } };
struct MapUqkv { const bf16_t* A1; const bf16_t* A2; const bf16_t* B1; const bf16_t* B2;
    DI const char* a(const Unit& u) const { return (const char*)((u.pn < 12 ? A1 : A2) + (size_t)u.pm * BM * 512); }
    DI const char* b(const Unit& u) const { return (const char*)(u.pn < 12 ? B1 + (size_t)u.pn * BM * 512 : B2 + (size_t)(u.pn - 12) * BM * 512); } };

template <class Map, class Epi>
DI void gemm_phase(LAS unsigned char* lds, const Map& MP, const Epi& E, const int nM, const int nN, const int K, const int lda, const int ldb) {
    const int tid = opaque_tid(), wid = __builtin_amdgcn_readfirstlane(tid >> 6), lane = tid & 63, wr = wid >> 2, wc = wid & 3, fr = lane & 15, fq = lane >> 4;
    const int nt = K / BK, G = gridDim.x, cblk = opaque_bid();
    unsigned voffA[2], voffB[2];
#pragma unroll
    for (int i = 0; i < 2; ++i) { int R, C; stage_rc(tid * 16 + i * 8192, R, C); const int Rb = Epi::PERM ? ((R & ~31) + perm32(R & 31)) : R;
        voffA[i] = (unsigned)(R * lda + C) * 2u; voffB[i] = (unsigned)(Rb * ldb + C) * 2u; }
    const size_t kstep = (size_t)(BK * 2);
    const size_t hstepA = (size_t)HALF * lda * 2, hstepB = (size_t)HALF * ldb * 2;
    const unsigned ldsw = (unsigned)wid * 1024u;
    const int aoff = lds_byte(wr * 64 + fr, fq * 8), boff = lds_byte(wc * 32 + fr, fq * 8);
#define PG8_SA(b, h) (((b) * 2 + (h)) * HTB)
#define PG8_SB(b, h) ((4 + (b) * 2 + (h)) * HTB)
#define PG8_STAGE(bufoff, gbase, voff) do { _Pragma("unroll") for (int _i = 0; _i < 2; ++_i) \
        __builtin_amdgcn_global_load_lds((const unsigned*)((const char*)(gbase) + (voff)[_i]), (LAS unsigned*)(lds + (bufoff) + ldsw + _i * 8192), 16, 0, 0); } while (0)
#define PG8_LDA(dst, b, h) do { _Pragma("unroll") for (int m = 0; m < 4; ++m) _Pragma("unroll") for (int k = 0; k < 2; ++k) dst[m][k] = *(const LAS bf16x8*)(lds + PG8_SA(b, h) + aoff + m * 2048 + k * 1024); } while (0)
#define PG8_LDB(dst, b, h) do { _Pragma("unroll") for (int n = 0; n < 2; ++n) _Pragma("unroll") for (int k = 0; k < 2; ++k) dst[n][k] = *(const LAS bf16x8*)(lds + PG8_SB(b, h) + boff + n * 2048 + k * 1024); } while (0)
#define PG8_MMA(ai, bj, At, Bt) do { __builtin_amdgcn_s_setprio(1); _Pragma("unroll") for (int m = 0; m < 4; ++m) _Pragma("unroll") for (int n = 0; n < 2; ++n) _Pragma("unroll") for (int k = 0; k < 2; ++k) \
        acc[ai][bj][m][n] = __builtin_amdgcn_mfma_f32_16x16x32_bf16(Bt[n][k], At[m][k], acc[ai][bj][m][n], 0, 0, 0); __builtin_amdgcn_s_setprio(0); } while (0)
#define PG8_WAIT_V(n) asm volatile("s_waitcnt vmcnt(" #n ")" ::: "memory")
#define PG8_WAIT_L(n) asm volatile("s_waitcnt lgkmcnt(" #n ")" ::: "memory")
#define PG8_BAR __builtin_amdgcn_s_barrier()
#define PG8_SCHED __builtin_amdgcn_sched_barrier(0)
    Unit cur, nxt; int ui = 0;
    if (!sched_next(0, nM, nN, G, cblk, cur)) return;
    f32x4 acc[2][2][4][2];
#pragma unroll
    for (int a = 0; a < 2; ++a)
#pragma unroll
        for (int b = 0; b < 2; ++b)
#pragma unroll
            for (int m = 0; m < 4; ++m)
#pragma unroll
                for (int n = 0; n < 2; ++n) acc[a][b][m][n] = (f32x4){0.f, 0.f, 0.f, 0.f};
    bf16x8 At[4][2], B0[2][2], B1[2][2];
    const char* cA = MP.a(cur); const char* cB = MP.b(cur);
    PG8_STAGE(PG8_SB(0, 0), cB, voffB); PG8_STAGE(PG8_SA(0, 0), cA, voffA); PG8_STAGE(PG8_SB(0, 1), cB + hstepB, voffB); PG8_STAGE(PG8_SA(0, 1), cA + hstepA, voffA);
    if (wr == 1) PG8_BAR;
    PG8_WAIT_V(4); PG8_BAR;
    PG8_STAGE(PG8_SB(1, 0), cB + kstep, voffB); PG8_STAGE(PG8_SA(1, 0), cA + kstep, voffA); PG8_STAGE(PG8_SB(1, 1), cB + hstepB + kstep, voffB);
    PG8_WAIT_V(6); PG8_BAR;
    for (;;) {
        const bool has_next = sched_next(ui + 1, nM, nN, G, cblk, nxt);
        const char* nA = has_next ? MP.a(nxt) : cA; const char* nB = has_next ? MP.b(nxt) : cB;
        for (int t = 0; t < nt; t += 2) {
            const bool last = (t == nt - 2);
            const char* a1 = cA + (size_t)(t + 1) * kstep;
            const char* a2 = last ? nA : cA + (size_t)(t + 2) * kstep; const char* b2 = last ? nB : cB + (size_t)(t + 2) * kstep;
            const char* a3 = a2 + kstep; const char* b3 = b2 + kstep;
            PG8_LDB(B0, 0, 0); PG8_SCHED; PG8_LDA(At, 0, 0); PG8_STAGE(PG8_SA(1, 1), a1 + hstepA, voffA);
            PG8_WAIT_L(8); PG8_BAR; PG8_WAIT_L(0); PG8_MMA(0, 0, At, B0); PG8_BAR; PG8_SCHED;
            PG8_LDB(B1, 0, 1); PG8_STAGE(PG8_SB(0, 0), b2, voffB);
            PG8_BAR; PG8_WAIT_L(0); PG8_MMA(0, 1, At, B1); PG8_BAR;
            PG8_LDA(At, 0, 1); PG8_STAGE(PG8_SA(0, 0), a2, voffA);
            PG8_BAR; PG8_WAIT_L(0); PG8_MMA(1, 0, At, B0); PG8_BAR; PG8_SCHED;
            PG8_STAGE(PG8_SB(0, 1), b2 + hstepB, voffB);
            PG8_WAIT_V(6); PG8_BAR; PG8_MMA(1, 1, At, B1); PG8_BAR;
            PG8_LDB(B0, 1, 0); PG8_SCHED; PG8_LDA(At, 1, 0); PG8_STAGE(PG8_SA(0, 1), a2 + hstepA, voffA);
            PG8_WAIT_L(8); PG8_BAR; PG8_WAIT_L(0); PG8_MMA(0, 0, At, B0); PG8_BAR; PG8_SCHED;
            PG8_LDB(B1, 1, 1); PG8_STAGE(PG8_SB(1, 0), b3, voffB);
            PG8_BAR; PG8_WAIT_L(0); PG8_MMA(0, 1, At, B1); PG8_BAR;
            PG8_LDA(At, 1, 1); PG8_STAGE(PG8_SA(1, 0), a3, voffA);
            PG8_BAR; PG8_WAIT_L(0); PG8_MMA(1, 0, At, B0); PG8_BAR; PG8_SCHED;
            PG8_STAGE(PG8_SB(1, 1), b3 + hstepB, voffB);
            PG8_WAIT_V(6); PG8_BAR; PG8_MMA(1, 1, At, B1); PG8_BAR;
        }
        { int frr = fr, fqq = fq; asm volatile("" : "+v"(frr), "+v"(fqq)); E(acc, cur, wr, wc, frr, fqq); }
        if (!has_next) break;
#pragma unroll
        for (int a = 0; a < 2; ++a)
#pragma unroll
            for (int b = 0; b < 2; ++b)
#pragma unroll
                for (int m = 0; m < 4; ++m)
#pragma unroll
                    for (int n = 0; n < 2; ++n) acc[a][b][m][n] = (f32x4){0.f, 0.f, 0.f, 0.f};
        cur = nxt; cA = nA; cB = nB; ++ui;
    }
    PG8_WAIT_V(0);
    if (wr == 0) PG8_BAR;
    PG8_BAR;
#undef PG8_SA
#undef PG8_SB
#undef PG8_STAGE
#undef PG8_LDA
#undef PG8_LDB
#undef PG8_MMA
#undef PG8_WAIT_V
#undef PG8_WAIT_L
#undef PG8_BAR
#undef PG8_SCHED
}


#define XB_TMO      128
#define XB_XCNT(j)  (256  + 64 * (j))
#define XB_XSUB(j)  (1280 + 64 * (j))
#define XB_XGEN(j)  (2304 + 64 * (j))
#define XB_TOP      3328
#define XB_TOPGEN   3392
#define XCD_BAR_WORDS 3456
#define XB_SPIN_CAP (1u << 18)
DI unsigned xb_ld(unsigned* p)              { return __hip_atomic_load(p, __ATOMIC_RELAXED, __HIP_MEMORY_SCOPE_AGENT); }
DI unsigned xb_add(unsigned* p, unsigned v) { return __hip_atomic_fetch_add(p, v, __ATOMIC_RELAXED, __HIP_MEMORY_SCOPE_AGENT); }
DI unsigned xb_xcc_id() { return (unsigned)__builtin_amdgcn_s_getreg((3 << 11) | 20) & 0xFu; }
#define XB_SPIN(cond, bar) do { unsigned _sp = 0; while (cond) { __builtin_amdgcn_s_sleep(1); \
    if ((++_sp & 255u) == 0u) { if (xb_ld(&(bar)[XB_TMO])) break; if (_sp > XB_SPIN_CAP) { atomicAdd(&(bar)[XB_TMO], 1u); break; } } } } while (0)
struct XcdBarrier { unsigned* bar; unsigned x; volatile LAS unsigned* st; };
DI XcdBarrier xcd_barrier_post(unsigned* bar, volatile LAS unsigned* st) {
    XcdBarrier b; b.bar = bar; b.x = xb_xcc_id(); b.st = st;
    if (threadIdx.x == 0) (void)xb_add(&bar[XB_XCNT(b.x)], 1u);
    return b;
}
DI void xcd_barrier_complete(unsigned* bar, unsigned x, unsigned& nloc, unsigned& nx) {
    const unsigned G = gridDim.x * gridDim.y * gridDim.z;
    unsigned sum, cnt, mine, sp = 0u;
    for (;;) {
        sum = 0u; cnt = 0u; mine = 0u;
#pragma unroll
        for (unsigned j = 0; j < 16; ++j) { const unsigned c = xb_ld(&bar[XB_XCNT(j)]); sum += c; cnt += (c > 0u) ? 1u : 0u; mine = (j == x) ? c : mine; }
        if (sum == G) break;
        __builtin_amdgcn_s_sleep(1);
        if ((++sp & 255u) == 0u) { if (xb_ld(&bar[XB_TMO])) break; if (sp > XB_SPIN_CAP) { atomicAdd(&bar[XB_TMO], 1u); break; } }
    }
    nloc = mine > 0u ? mine : 1u; nx = cnt > 0u ? cnt : 1u;
}
DI void xcd_barrier(const XcdBarrier& b) {
    asm volatile("s_waitcnt vmcnt(0)" ::: "memory");
    __syncthreads();
    if (threadIdx.x == 0) {
        unsigned* bar = b.bar;
        __builtin_amdgcn_s_waitcnt(0);
        unsigned nloc = b.st[0], nx = b.st[1];
        if (nloc == 0u) { xcd_barrier_complete(bar, b.x, nloc, nx); b.st[0] = nloc; b.st[1] = nx; }
        const unsigned old = xb_add(&bar[XB_XSUB(b.x)], 1u);
        const unsigned gen = old / nloc;
        if (old + 1u == (gen + 1u) * nloc) {
            __builtin_amdgcn_fence(__ATOMIC_RELEASE, "agent");
            asm volatile("s_waitcnt vmcnt(0)" ::: "memory");
            const unsigned og = xb_add(&bar[XB_TOP], 1u);
            const unsigned tg = og / nx;
            if (og + 1u == (tg + 1u) * nx) xb_add(&bar[XB_TOPGEN], 1u);
            else XB_SPIN(xb_ld(&bar[XB_TOPGEN]) == tg, bar);
            __builtin_amdgcn_fence(__ATOMIC_ACQUIRE, "agent");
            xb_add(&bar[XB_XGEN(b.x)], 1u);
            asm volatile("s_waitcnt vmcnt(0)" ::: "memory");
        } else {
            XB_SPIN(xb_ld(&bar[XB_XGEN(b.x)]) == gen, bar);
            __builtin_amdgcn_fence(__ATOMIC_ACQUIRE, "agent");
            asm volatile("s_waitcnt vmcnt(0)" ::: "memory");
        }
    }
    __syncthreads();
}

#define PH(...) do { if (MEGA || phase == idx) { unsigned char* const wsl = wsp(p); (void)wsl; __VA_ARGS__; } if (MEGA) { for (int _s = 0; _s < REP_SYNC; ++_s) { if (p.njobs < 0) grid.sync(); xcd_barrier(xb); } } ++idx; } while (0)
#define PHR(REP, ...) _Pragma("unroll 1") for (int rep = 0; rep < (REP); ++rep) { float* const xo = (rep == (REP) - 1) ? p.out : (float*)(p.ws + OFF_QN); (void)xo; PH(__VA_ARGS__); }
template <bool MEGA, int layer>
DI void run_layer(const Params& p, LAS unsigned char* lds, int& idx, const int phase, const XcdBarrier& xb, cg::grid_group& grid) {
    constexpr int kind = layer % 3, j = layer / 3;
        const float* gmix = p.norm_mix_g + layer * D;
    unsigned char* const wsl0 = wsp(p); (void)wsl0;
        if constexpr (kind == 0) {
            const void* xin = layer == 0 ? (const void*)p.x_in : (const void*)(wsl0 + OFF_XB);
            if constexpr (layer != 0) { PHR(REP_MISC, if (EN(1)) rstd_phase<true>(p, xin)); }
            PHR(REP_MISC, if (EN(2)) pool_phase<layer != 0>(p, xin, gmix));
            PHR(REP_GEMM, if (EN(3)) { MapPool mp{(const bf16_t*)(wsl + OFF_H), (const bf16_t*)(wsl + OFF_WPOOL) + (size_t)j * 4 * 512 * 512}; EpiRes<layer != 0, true> ep{xin, wsl + OFF_XB, p.pool_scale + j * D};
                 gemm_phase(lds, mp, ep, 64, 8, 512, 2048, 512); });
        } else if constexpr (kind == 1) {
            PHR(REP_MISC, if (EN(4)) norm_phase<true>(p, wsl + OFF_XB, gmix));
            PHR(REP_GEMM, if (EN(5)) { MapPlain mp{(const bf16_t*)(wsl + OFF_H), (const bf16_t*)(wsl + OFF_WQKV), 2048, 2048}; EpiBf16 ep{(bf16_t*)(wsl + OFF_QKV32), 2560, nullptr, 0, 1 << 30};
                 gemm_phase(lds, mp, ep, 64, 10, 2048, 2048, 2048); });
            PHR(REP_MISC, if (EN(6)) swa_prep_phase(p));
            PHR(REP_ATTN, if (EN(7)) swa_attn_phase(p, lds));
            PHR(REP_GEMM, if (EN(8)) { MapPlain mp{(const bf16_t*)(wsl + OFF_H), (const bf16_t*)(wsl + OFF_WSWAO), 2048, 2048}; EpiRes<true, true> ep{wsl + OFF_XB, wsl + OFF_XB, nullptr};
                 gemm_phase(lds, mp, ep, 64, 8, 2048, 2048, 2048); });
        } else {
            PHR(REP_MISC, if (EN(9)) norm_phase<true>(p, wsl + OFF_XB, gmix));
            PHR(REP_GEMM, if (EN(10)) { MapPlain mp{(const bf16_t*)(wsl + OFF_H), (const bf16_t*)(wsl + OFF_WDOWN), 2048, 2048}; EpiBf16 ep{(bf16_t*)(wsl + OFF_D32), 1280, nullptr, 0, 1 << 30};
                 gemm_phase(lds, mp, ep, 64, 5, 2048, 2048, 2048); });
            PHR(REP_MISC, if (EN(11)) mla_prep1_phase(p));
            PHR(REP_GEMM, if (EN(12)) { MapUqkv mp{(const bf16_t*)(wsl + OFF_CQ), (const bf16_t*)(wsl + OFF_CKV), (const bf16_t*)(wsl + OFF_WUQ), (const bf16_t*)(wsl + OFF_WUKV)};
                 EpiBf16 ep{(bf16_t*)(wsl + OFF_Q32), 3072, (bf16_t*)(wsl + OFF_KV32), 4096, 12};
                 gemm_phase(lds, mp, ep, 64, 28, 512, 512, 512); });
            PHR(REP_MISC, if (EN(13)) mla_prep2_phase(p));
            PHR(REP_ATTN, if (EN(14)) mla_attn_phase(p, lds));
            PHR(REP_GEMM, if (EN(15)) { MapPlain mp{(const bf16_t*)(wsl + OFF_H), (const bf16_t*)(wsl + OFF_WMLAO), 2048, 2048}; EpiRes<true, true> ep{wsl + OFF_XB, wsl + OFF_XB, nullptr};
                 gemm_phase(lds, mp, ep, 64, 8, 2048, 2048, 2048); });
        }
        PHR(REP_MISC, if (EN(16)) norm_phase<true>(p, wsl + OFF_XB, p.norm_ffn_g + layer * D));
        PHR(REP_GEMM, if (EN(17)) { MapPlain mp{(const bf16_t*)(wsl + OFF_H), (const bf16_t*)(wsl + OFF_WFIN) + (size_t)layer * 11264 * 2048, 2048, 2048};
             EpiGlu ep{p.ffn_conv_w + (size_t)layer * 3 * DFF, p.ffn_conv_b + (size_t)layer * DFF, (bf16_t*)(wsl + OFF_ACT), (float*)(wsl + OFF_EP), (float*)(wsl + OFF_ER), (float*)(wsl + OFF_EV)};
             gemm_phase(lds, mp, ep, 64, 44, 2048, 2048, 2048); });
        PHR(REP_MISC, if (EN(18)) glu_fix_phase(p, layer));
        PHR(REP_GEMM, if (EN(19)) { MapPlain mp{(const bf16_t*)(wsl + OFF_ACT), (const bf16_t*)(wsl + OFF_WFOUT) + (size_t)layer * 2048 * 5632, 5632, 5632}; EpiRes<true, layer != 3> ep{wsl + OFF_XB, layer == 3 ? (void*)p.out : (void*)(wsl + OFF_XB), nullptr};
             gemm_phase(lds, mp, ep, 64, 8, 5632, 5632, 5632); });
}

template <bool MEGA>
__global__ void __launch_bounds__(512) fwd_kernel(Params p, int phase) {
    extern __shared__ __attribute__((aligned(16))) unsigned char lds_raw[];
    LAS unsigned char* lds = (LAS unsigned char*)lds_raw;
    cg::grid_group grid = cg::this_grid();
    int idx = 0;
    volatile LAS unsigned* xst = (volatile LAS unsigned*)(lds + LDS_STAGE);
    if (threadIdx.x == 0) { xst[0] = 0u; xst[1] = 0u; xst[2] = 0u; xst[3] = 0u; }
    __syncthreads();
    const XcdBarrier xb = xcd_barrier_post((unsigned*)(p.ws + OFF_BAR), xst);
    PHR(REP_MISC, if (EN(0)) convert_phase(p, lds); rstd_phase<false>(p, p.x_in));
    run_layer<MEGA, 0>(p, lds, idx, phase, xb, grid);
    run_layer<MEGA, 1>(p, lds, idx, phase, xb, grid);
    run_layer<MEGA, 2>(p, lds, idx, phase, xb, grid);
    run_layer<MEGA, 3>(p, lds, idx, phase, xb, grid);
#undef PH
#undef PHR
}

__global__ void nan_fill(float* out, int n) { for (int i = blockIdx.x * blockDim.x + threadIdx.x; i < n; i += gridDim.x * blockDim.x) out[i] = __uint_as_float(0x7fc00000u); }

extern "C" void kernel_launch(void* const* d_in, const int* in_sizes, int n_in, void* d_out, int out_size, void* d_ws, size_t ws_size, hipStream_t stream) {
    if (ws_size < WS_END || n_in < 25) { fprintf(stderr, "kernel_launch: workspace too small (%zu < %zu) or bad n_in %d\n", ws_size, (size_t)WS_END, n_in);
        nan_fill<<<256, 256, 0, stream>>>((float*)d_out, out_size); return; }
    Params p{};
    p.x_in = (const float*)d_in[0]; p.positions = (const int*)d_in[1]; p.norm_mix_g = (const float*)d_in[2]; p.norm_ffn_g = (const float*)d_in[3];
    p.pool_scale = (const float*)d_in[5]; p.swa_q_gain = (const float*)d_in[7]; p.swa_k_gain = (const float*)d_in[8]; p.swa_sinks = (const float*)d_in[9];
    p.mla_q_a_gain = (const float*)d_in[12]; p.mla_kv_a_gain = (const float*)d_in[13]; p.mla_qn_gain = (const float*)d_in[16]; p.mla_qr_gain = (const float*)d_in[17];
    p.mla_kn_gain = (const float*)d_in[18]; p.mla_kr_gain = (const float*)d_in[19]; p.ffn_conv_w = (const float*)d_in[22]; p.ffn_conv_b = (const float*)d_in[23];
    p.out = (float*)d_out; p.ws = (unsigned char*)d_ws;
    unsigned char* ws = (unsigned char*)d_ws; int nj = 0;
    auto add = [&](const float* src, size_t off, int K, int N, int mode = 0) { p.jobs[nj].src = src; p.jobs[nj].dst = (bf16_t*)(ws + off); p.jobs[nj].K = K; p.jobs[nj].N = N; p.jobs[nj].mode = mode; ++nj; };
    for (int g = 0; g < 8; ++g) add((const float*)d_in[4] + (size_t)g * 512 * 512, OFF_WPOOL + (size_t)g * 512 * 512 * 2, 512, 512);
    add((const float*)d_in[6], OFF_WQKV, 2048, 2560);
    add((const float*)d_in[10], OFF_WSWAO, 2048, 2048);
    add((const float*)d_in[11], OFF_WDOWN, 2048, 1088);
    add((const float*)d_in[14], OFF_WUQ, 512, 3072);
    add((const float*)d_in[15], OFF_WUKV, 512, 4096);
    add((const float*)d_in[20], OFF_WMLAO, 2048, 2048);
    for (int i = 0; i < 4; ++i) add((const float*)d_in[21] + (size_t)i * 2048 * 11264, OFF_WFIN + (size_t)i * 11264 * 2048 * 2, 2048, 11264, 1);
    for (int i = 0; i < 4; ++i) add((const float*)d_in[24] + (size_t)i * 5632 * 2048, OFF_WFOUT + (size_t)i * 2048 * 5632 * 2, 5632, 2048);
    p.njobs = nj;
    static int grid_blocks = 0;
    if (!grid_blocks) {
        int dev = 0, cus = 0, per_cu = 0;
        (void)hipGetDevice(&dev); (void)hipDeviceGetAttribute(&cus, hipDeviceAttributeMultiprocessorCount, dev);
        (void)hipFuncSetAttribute((const void*)fwd_kernel<MEGA_MODE != 0>, hipFuncAttributeMaxDynamicSharedMemorySize, LDS_BYTES);
        (void)hipOccupancyMaxActiveBlocksPerMultiprocessor(&per_cu, (const void*)fwd_kernel<MEGA_MODE != 0>, 512, LDS_BYTES);
        if (per_cu < 1) per_cu = 1;
        if (per_cu > 1) per_cu = 1;
        if (cus < 1) cus = 256;
        grid_blocks = cus * per_cu; (void)hipGetLastError();
    }
    (void)hipMemsetAsync((unsigned char*)d_ws + OFF_BAR, 0, 16384, stream);
#if MEGA_MODE
    int ph = -1; void* args[] = {&p, &ph};
    hipError_t e = hipLaunchCooperativeKernel((const void*)fwd_kernel<true>, dim3(grid_blocks), dim3(512), args, LDS_BYTES, stream);
    if (e != hipSuccess) fprintf(stderr, "cooperative launch failed: %s (grid %d)\n", hipGetErrorString(e), grid_blocks);
#else
    for (int ph = 0; ph < NPHASES; ++ph) hipLaunchKernelGGL(fwd_kernel<false>, dim3(grid_blocks), dim3(512), LDS_BYTES, stream, p, ph);
#endif
}
```

```cpp
#include <hip/hip_runtime.h>
#include <hip/hip_cooperative_groups.h>
#include <cstdio>
namespace cg = cooperative_groups;

#ifndef MEGA_MODE
#define MEGA_MODE 1
#endif

#ifndef PHMASK
#define PHMASK 0xffffffffu
#endif
#define EN(k) ((PHMASK >> (k)) & 1u)
#ifndef REP_GEMM
#define REP_GEMM 1
#endif
#ifndef REP_ATTN
#define REP_ATTN 1
#endif
#ifndef REP_SYNC
#define REP_SYNC 1
#endif
#ifndef REP_MISC
#define REP_MISC 1
#endif
#define LAS __attribute__((address_space(3)))
#define DI __device__ __forceinline__
typedef unsigned short bf16_t;
typedef short bf16x8 __attribute__((ext_vector_type(8)));
typedef short s16x4 __attribute__((ext_vector_type(4)));
typedef float f32x2 __attribute__((ext_vector_type(2)));
typedef float f32x4 __attribute__((ext_vector_type(4)));
typedef float f32x16 __attribute__((ext_vector_type(16)));
typedef unsigned u32x2 __attribute__((ext_vector_type(2)));
typedef unsigned u32x4 __attribute__((ext_vector_type(4)));
typedef __bf16 hwbf16x2 __attribute__((ext_vector_type(2)));

constexpr int T = 16384, S = 4096, D = 2048, DFF = 5632;
constexpr float EPS = 1e-6f;
constexpr float LOG2E = 1.4426950408889634f;
constexpr int LDS_STAGE = 131072;
constexpr int LDS_BYTES = LDS_STAGE + 16;
constexpr int NPHASES = 34;

constexpr size_t OFF_WPOOL = 0;
constexpr size_t OFF_WQKV  = OFF_WPOOL + (size_t)2 * 4 * 512 * 512 * 2;
constexpr size_t OFF_WSWAO = OFF_WQKV + (size_t)2560 * 2048 * 2;
constexpr size_t OFF_WDOWN = OFF_WSWAO + (size_t)2048 * 2048 * 2;
constexpr size_t OFF_WUQ   = OFF_WDOWN + (size_t)1280 * 2048 * 2;
constexpr size_t OFF_WUKV  = OFF_WUQ + (size_t)3072 * 512 * 2;
constexpr size_t OFF_WMLAO = OFF_WUKV + (size_t)4096 * 512 * 2;
constexpr size_t OFF_WFIN  = OFF_WMLAO + (size_t)2048 * 2048 * 2;
constexpr size_t OFF_WFOUT = OFF_WFIN + (size_t)4 * 11264 * 2048 * 2;
constexpr size_t OFF_ROPE  = OFF_WFOUT + (size_t)4 * 2048 * 5632 * 2;
constexpr size_t OFF_RSTD  = OFF_ROPE + (size_t)S * 32 * 4 * 2;
constexpr size_t OFF_H     = OFF_RSTD + (size_t)T * 4;
constexpr size_t OFF_SCR   = OFF_H + (size_t)T * D * 2;
constexpr size_t OFF_U     = OFF_SCR;
constexpr size_t OFF_ACT   = OFF_U + (size_t)T * 11264 * 2;
constexpr size_t OFF_QKV32 = OFF_SCR;
constexpr size_t OFF_QS    = OFF_QKV32 + (size_t)T * 2560 * 4;
constexpr size_t OFF_KS    = OFF_QS + (size_t)T * 2048 * 2;
constexpr size_t OFF_VTS   = OFF_KS + (size_t)T * 256 * 2;
constexpr size_t OFF_D32   = OFF_SCR;
constexpr size_t OFF_CQ    = OFF_D32 + (size_t)T * 1280 * 4;
constexpr size_t OFF_CKV   = OFF_CQ + (size_t)T * 512 * 2;
constexpr size_t OFF_KPE   = OFF_CKV + (size_t)T * 512 * 2;
constexpr size_t OFF_Q32   = OFF_KPE + (size_t)T * 64 * 2;
constexpr size_t OFF_KV32  = OFF_Q32 + (size_t)T * 3072 * 4;
constexpr size_t OFF_QN    = OFF_KV32 + (size_t)T * 4096 * 4;
constexpr size_t OFF_KC    = OFF_QN + (size_t)T * 16 * 192 * 2;
constexpr size_t OFF_VT    = OFF_KC + (size_t)T * 16 * 192 * 2;
constexpr size_t OFF_BAR   = OFF_VT + (size_t)T * 2048 * 2;
constexpr size_t OFF_EP    = OFF_BAR + 16384;
constexpr size_t OFF_ER    = OFF_EP + (size_t)512 * DFF * 4;
constexpr size_t OFF_EV    = OFF_ER + (size_t)512 * DFF * 4;
constexpr size_t OFF_XB    = OFF_EV + (size_t)512 * DFF * 4;
constexpr size_t WS_END    = OFF_XB + (size_t)T * D * 2;

struct Job { const float* src; bf16_t* dst; int K, N, mode, pad; };
struct Params {
    const float* x_in; const int* positions; const float* norm_mix_g; const float* norm_ffn_g;
    const float* pool_scale; const float* swa_q_gain; const float* swa_k_gain; const float* swa_sinks;
    const float* mla_q_a_gain; const float* mla_kv_a_gain; const float* mla_qn_gain; const float* mla_qr_gain;
    const float* mla_kn_gain; const float* mla_kr_gain; const float* ffn_conv_w; const float* ffn_conv_b;
    float* out; unsigned char* ws;
    Job jobs[22]; int njobs; int pad;
};

DI unsigned char* wsp(const Params& p) { const unsigned long long a = (unsigned long long)p.ws; unsigned lo = __builtin_amdgcn_readfirstlane((unsigned)a), hi = __builtin_amdgcn_readfirstlane((unsigned)(a >> 32)); asm volatile("" : "+s"(lo), "+s"(hi)); return (unsigned char*)(((unsigned long long)hi << 32) | lo); }
#define WSP wsp(p)
DI unsigned pack2(float a, float b) { f32x2 v = {a, b}; hwbf16x2 r = __builtin_convertvector(v, hwbf16x2); return __builtin_bit_cast(unsigned, r); }
DI bf16_t f2bf(float a) { return (bf16_t)(pack2(a, 0.f) & 0xffffu); }
DI float bf2f(unsigned short b) { return __uint_as_float(((unsigned)b) << 16); }
DI float bflo(unsigned w) { return __uint_as_float(w << 16); }
DI float bfhi(unsigned w) { return __uint_as_float(w & 0xffff0000u); }
template <int CTRL> DI float dppf(float v) { return __builtin_bit_cast(float, __builtin_amdgcn_update_dpp(0, __builtin_bit_cast(int, v), CTRL, 0xf, 0xf, false)); }
DI float sum16(float v) { v += dppf<0x128>(v); v += dppf<0x124>(v); v += dppf<0x122>(v); v += dppf<0x121>(v); return v; }
DI f32x2 swap16(float v) { auto r = __builtin_amdgcn_permlane16_swap(__builtin_bit_cast(unsigned, v), __builtin_bit_cast(unsigned, v), false, false); return (f32x2){__builtin_bit_cast(float, r[0]), __builtin_bit_cast(float, r[1])}; }
DI f32x2 swap32(float v) { auto r = __builtin_amdgcn_permlane32_swap(__builtin_bit_cast(unsigned, v), __builtin_bit_cast(unsigned, v), false, false); return (f32x2){__builtin_bit_cast(float, r[0]), __builtin_bit_cast(float, r[1])}; }
DI float xsum32(float v) { return v + __shfl_xor(v, 32); }
DI float xmax32(float v) { return fmaxf(v, __shfl_xor(v, 32)); }
DI float wave_sum(float v) { for (int o = 32; o; o >>= 1) v += __shfl_xor(v, o); return v; }
DI float fast_exp2(float x) { return __builtin_amdgcn_exp2f(x); }
DI float dpp_ror1(float v)  { return __builtin_bit_cast(float, __builtin_amdgcn_update_dpp(0, __builtin_bit_cast(int, v), 0x121, 0xf, 0xf, false)); }
DI float dpp_ror15(float v) { return __builtin_bit_cast(float, __builtin_amdgcn_update_dpp(0, __builtin_bit_cast(int, v), 0x12F, 0xf, 0xf, false)); }
DI float silu_mul(float g, float v) { return g * v * __builtin_amdgcn_rcpf(1.0f + __builtin_amdgcn_exp2f(-LOG2E * g)); }
template <bool BF> DI f32x4 ldx4(const void* base, size_t e) {
    if constexpr (BF) { const u32x2 w = *(const u32x2*)((const bf16_t*)base + e); return (f32x4){__uint_as_float(w[0] << 16), __uint_as_float(w[0] & 0xffff0000u), __uint_as_float(w[1] << 16), __uint_as_float(w[1] & 0xffff0000u)}; }
    else return *(const f32x4*)((const float*)base + e);
}
DI int opaque_bid() { int b = blockIdx.x; asm volatile("" : "+s"(b)); return b; }
DI int opaque_tid() { int t = threadIdx.x; asm volatile("" : "+v"(t)); return t; }

DI void convert_phase(const Params& p, LAS unsigned char* lds) {
    unsigned char* const ws = wsp(p);
    const int bid = opaque_bid();
    LAS float* tile = (LAS float*)lds;
    const int tid = opaque_tid();
    for (int j = 0; j < p.njobs; ++j) {
        const float* src = p.jobs[j].src; bf16_t* dst = p.jobs[j].dst; const int K = p.jobs[j].K, N = p.jobs[j].N, mode = p.jobs[j].mode;
        const int nn = (N + 255) >> 8, ntile = (K >> 6) * nn;
        for (int ti = bid; ti < ntile; ti += gridDim.x) {
            const int tk = ti / nn, tn = ti - tk * nn;
            const int rr = tid >> 6, c4 = tid & 63, col = tn * 256 + c4 * 4;
            if (col < N) {
                f32x4 v[8];
#pragma unroll
                for (int i = 0; i < 8; ++i) v[i] = *(const f32x4*)(src + (size_t)(tk * 64 + rr + 8 * i) * N + col);
#pragma unroll
                for (int i = 0; i < 8; ++i) { LAS float* tp = tile + (rr + 8 * i) * 257 + c4 * 4; tp[0] = v[i][0]; tp[1] = v[i][1]; tp[2] = v[i][2]; tp[3] = v[i][3]; }
            }
            __syncthreads();
            const int k8 = (tid & 7) * 8;
#pragma unroll
            for (int r = 0; r < 4; ++r) {
                const int nl = (tid >> 3) + 64 * r, cbase = tn * 256 + 64 * r;
                if (cbase < N) {
                    u32x4 o;
#pragma unroll
                    for (int q = 0; q < 4; ++q) o[q] = pack2(tile[(k8 + 2 * q) * 257 + nl], tile[(k8 + 2 * q + 1) * 257 + nl]);
                    int orow = cbase;
                    if (mode) { const int hv = orow >= DFF, ch = orow - (hv ? DFF : 0); orow = (ch >> 7) * 256 + hv * 128 + (ch & 127); }
                    *(u32x4*)(dst + (size_t)(orow + (nl & 63)) * K + tk * 64 + k8) = o;
                }
            }
            __syncthreads();
        }
    }
    const int gtid = bid * 512 + tid, gsz = gridDim.x * 512;
    { u32x4* z = (u32x4*)(ws + OFF_WDOWN + (size_t)1088 * 2048 * 2); const int n16 = 192 * 2048 * 2 / 16;
      for (int i = gtid; i < n16; i += gsz) z[i] = (u32x4){0u, 0u, 0u, 0u}; }
    { float* ct = (float*)(ws + OFF_ROPE); float* st = ct + S * 32;
      for (int i = gtid; i < S * 32; i += gsz) { const int s = i >> 5, f = i & 31;
          const double inv = pow(10000.0, -(double)f / 32.0); const double a = (double)p.positions[s] * inv;
          ct[i] = (float)cos(a); st[i] = (float)sin(a); } }
}

template <bool BF> DI void rstd_phase(const Params& p, const void* x) {
    unsigned char* const ws = wsp(p);
    const int bid = opaque_bid();
    float* rstd = (float*)(ws + OFF_RSTD);
    const int tid = opaque_tid(), wid = tid >> 6, lane = tid & 63;
    for (int t = bid * 8 + wid; t < T; t += gridDim.x * 8) {
        float ss = 0.f;
#pragma unroll
        for (int i = 0; i < 8; ++i) { const f32x4 v = ldx4<BF>(x, (size_t)t * D + (i * 64 + lane) * 4); ss += v[0] * v[0] + v[1] * v[1] + v[2] * v[2] + v[3] * v[3]; }
        ss = wave_sum(ss);
        if (lane == 0) rstd[t] = rsqrtf(ss * (1.0f / D) + EPS);
    }
}

template <bool BF> DI void norm_phase(const Params& p, const void* x, const float* gain) {
    unsigned char* const ws = wsp(p);
    const int bid = opaque_bid();
    bf16_t* H = (bf16_t*)(ws + OFF_H);
    const int tid = opaque_tid(), wid = tid >> 6, lane = tid & 63;
    const int step = gridDim.x * 8;
    for (int t = bid * 8 + wid; t < T; t += 2 * step) {
        const int t2 = (t + step < T) ? t + step : t;
        f32x4 v[2][8];
#pragma unroll
        for (int q = 0; q < 2; ++q) {
            const int tt = q ? t2 : t;
#pragma unroll
            for (int i = 0; i < 4; ++i) {
                const size_t e = (size_t)tt * D + (i * 64 + lane) * 8;
                if constexpr (BF) { const u32x4 w = *(const u32x4*)((const bf16_t*)x + e);
                    v[q][2 * i] = (f32x4){bflo(w[0]), bfhi(w[0]), bflo(w[1]), bfhi(w[1])}; v[q][2 * i + 1] = (f32x4){bflo(w[2]), bfhi(w[2]), bflo(w[3]), bfhi(w[3])}; }
                else { v[q][2 * i] = *(const f32x4*)((const float*)x + e); v[q][2 * i + 1] = *(const f32x4*)((const float*)x + e + 4); }
            }
        }
        float ss[2] = {0.f, 0.f};
#pragma unroll
        for (int q = 0; q < 2; ++q)
#pragma unroll
            for (int i = 0; i < 8; ++i) ss[q] += v[q][i][0] * v[q][i][0] + v[q][i][1] * v[q][i][1] + v[q][i][2] * v[q][i][2] + v[q][i][3] * v[q][i][3];
        ss[0] = wave_sum(ss[0]); ss[1] = wave_sum(ss[1]);
#pragma unroll
        for (int q = 0; q < 2; ++q) {
            const int tt = q ? t2 : t;
            const float rs = rsqrtf(ss[q] * (1.0f / D) + EPS);
#pragma unroll
            for (int i = 0; i < 4; ++i) { const int c = (i * 64 + lane) * 8;
                const f32x4 g0 = *(const f32x4*)(gain + c), g1 = *(const f32x4*)(gain + c + 4);
                const f32x4 a = v[q][2 * i] * rs * g0, d = v[q][2 * i + 1] * rs * g1;
                u32x4 o; o[0] = pack2(a[0], a[1]); o[1] = pack2(a[2], a[3]); o[2] = pack2(d[0], d[1]); o[3] = pack2(d[2], d[3]);
                *(u32x4*)(H + (size_t)tt * D + c) = o; }
        }
    }
}

template <bool BF> DI void pool_phase(const Params& p, const void* x, const float* gain) {
    unsigned char* const ws = wsp(p);
    const int bid = opaque_bid();
    bf16_t* H = (bf16_t*)(ws + OFF_H); const float* rstd = (const float*)(ws + OFF_RSTD);
    const int tid = opaque_tid(), g = tid >> 7, left = 1 << g, right = (1 << g) - 1;
    const f32x4 gn = ((const f32x4*)gain)[tid];
    const int per = (T + gridDim.x - 1) / gridDim.x;
    if (gridDim.x == 256) {
        const int tb = bid * 64;
        f32x4 sm[4]; int pl[4], ph[4];
#pragma unroll
        for (int c = 0; c < 4; ++c) {
            const int t = tb + 16 * c, b = t / S, s = t - b * S;
            const int lo = max(s - left, 0), hi = min(s + right + 1, S);
            sm[c] = (f32x4){0.f, 0.f, 0.f, 0.f};
            for (int u = lo; u < hi; ++u) { const int tu = b * S + u; sm[c] += ldx4<BF>(x, (size_t)tu * D + tid * 4) * rstd[tu]; }
            pl[c] = lo; ph[c] = hi;
        }
        for (int i = 0; i < 16; ++i) {
            f32x4 va[4], vs[4], vm[4]; float ra[4], rs[4], rm[4], rc[4];
#pragma unroll
            for (int c = 0; c < 4; ++c) {
                const int t = tb + 16 * c + i, b = t / S, s = t - b * S;
                const int lo = max(s - left, 0), hi = min(s + right + 1, S);
                const int ta = b * S + hi - 1, ts = b * S + pl[c];
                va[c] = ldx4<BF>(x, (size_t)ta * D + tid * 4); vs[c] = ldx4<BF>(x, (size_t)ts * D + tid * 4); vm[c] = ldx4<BF>(x, (size_t)t * D + tid * 4);
                ra[c] = (i > 0 && hi > ph[c]) ? rstd[ta] : 0.f; rs[c] = (i > 0 && lo > pl[c]) ? rstd[ts] : 0.f; rm[c] = rstd[t];
                rc[c] = 1.0f / (float)(hi - lo); pl[c] = lo; ph[c] = hi;
            }
#pragma unroll
            for (int c = 0; c < 4; ++c) {
                const int t = tb + 16 * c + i;
                sm[c] += va[c] * ra[c] - vs[c] * rs[c];
                const f32x4 o = (sm[c] * rc[c] - vm[c] * rm[c]) * gn;
                u32x2 w; w[0] = pack2(o[0], o[1]); w[1] = pack2(o[2], o[3]);
                *(u32x2*)(H + (size_t)t * D + tid * 4) = w;
            }
        }
        return;
    }
    const int t0 = bid * per, t1 = min((bid + 1) * per, T);
    f32x4 sum = {0.f, 0.f, 0.f, 0.f}; int plo = 0, phi = 0;
    for (int t = t0; t < t1; ++t) {
        const int b = t / S, s = t - b * S;
        const int lo = max(s - left, 0), hi = min(s + right + 1, S);
        if (t == t0 || s == 0) {
            sum = (f32x4){0.f, 0.f, 0.f, 0.f};
            for (int u = lo; u < hi; ++u) { const int tu = b * S + u; const float r = rstd[tu]; const f32x4 v = ldx4<BF>(x, (size_t)tu * D + tid * 4); sum += v * r; }
        } else {
            if (hi > phi) { const int tu = b * S + hi - 1; sum += ldx4<BF>(x, (size_t)tu * D + tid * 4) * rstd[tu]; }
            if (lo > plo) { const int tu = b * S + plo;    sum -= ldx4<BF>(x, (size_t)tu * D + tid * 4) * rstd[tu]; }
        }
        plo = lo; phi = hi;
        const float rc = 1.0f / (float)(hi - lo);
        const f32x4 me = ldx4<BF>(x, (size_t)t * D + tid * 4) * rstd[t];
        const f32x4 o = (sum * rc - me) * gn;
        u32x2 w; w[0] = pack2(o[0], o[1]); w[1] = pack2(o[2], o[3]);
        *(u32x2*)(H + (size_t)t * D + tid * 4) = w;
    }
}

DI void glu_phase(const Params& p, int layer) {
    unsigned char* const ws = wsp(p);
    const int bid = opaque_bid();
    const bf16_t* U = (const bf16_t*)(ws + OFF_U); bf16_t* ACT = (bf16_t*)(ws + OFF_ACT);
    const float* cw = p.ffn_conv_w + (size_t)layer * 3 * DFF; const float* cb = p.ffn_conv_b + (size_t)layer * DFF;
    constexpr int NFG = DFF / 8, CH = 32, NTC = T / CH;
    const int tid = opaque_tid();
    for (int task = bid * 512 + tid; task < NFG * NTC; task += gridDim.x * 512) {
        const int tc = task / NFG, fg = task - tc * NFG, f0 = fg * 8, t0 = tc * CH;
        float w0[8], w1[8], w2[8], bb[8];
#pragma unroll
        for (int q = 0; q < 2; ++q) { const f32x4 a = *(const f32x4*)(cw + f0 + 4 * q), b = *(const f32x4*)(cw + DFF + f0 + 4 * q), c = *(const f32x4*)(cw + 2 * DFF + f0 + 4 * q), d = *(const f32x4*)(cb + f0 + 4 * q);
#pragma unroll
            for (int e = 0; e < 4; ++e) { w0[4 * q + e] = a[e]; w1[4 * q + e] = b[e]; w2[4 * q + e] = c[e]; bb[4 * q + e] = d[e]; } }
        const int s0 = t0 & (S - 1);
        u32x4 prev = {0u, 0u, 0u, 0u}, cur, nxt;
        if (s0 != 0) prev = *(const u32x4*)(U + (size_t)(t0 - 1) * 11264 + f0);
        cur = *(const u32x4*)(U + (size_t)t0 * 11264 + f0);
        for (int i = 0; i < CH; ++i) {
            const int t = t0 + i, s = s0 + i;
            nxt = (u32x4){0u, 0u, 0u, 0u};
            if (s != S - 1) nxt = *(const u32x4*)(U + (size_t)(t + 1) * 11264 + f0);
            const u32x4 vv = *(const u32x4*)(U + (size_t)t * 11264 + DFF + f0);
            u32x4 o;
#pragma unroll
            for (int q = 0; q < 4; ++q) {
                const float g0 = w0[2 * q] * bflo(prev[q]) + w1[2 * q] * bflo(cur[q]) + w2[2 * q] * bflo(nxt[q]) + bb[2 * q];
                const float g1 = w0[2 * q + 1] * bfhi(prev[q]) + w1[2 * q + 1] * bfhi(cur[q]) + w2[2 * q + 1] * bfhi(nxt[q]) + bb[2 * q + 1];
                const float a0 = g0 / (1.0f + __expf(-g0)) * bflo(vv[q]);
                const float a1 = g1 / (1.0f + __expf(-g1)) * bfhi(vv[q]);
                o[q] = pack2(a0, a1);
            }
            *(u32x4*)(ACT + (size_t)t * DFF + f0) = o;
            prev = cur; cur = nxt;
        }
    }
}

DI void glu_fix_phase(const Params& p, int layer) {
    unsigned char* const ws = wsp(p);
    const int bid = opaque_bid(), tid = opaque_tid();
    bf16_t* ACT = (bf16_t*)(ws + OFF_ACT);
    const float* EP = (const float*)(ws + OFF_EP); const float* ER = (const float*)(ws + OFF_ER); const float* EV = (const float*)(ws + OFF_EV);
    const float* cw = p.ffn_conv_w + (size_t)layer * 3 * DFF;
    constexpr int NC4 = DFF / 4, NTASK = 512 * NC4;
    const int tstride = gridDim.x * 512;
    for (int task0 = bid * 512 + tid; task0 < NTASK; task0 += 3 * tstride) {
        f32x4 gc[3], vv[3], nb[3], wv[3]; int rowc[3], cc[3];
#pragma unroll
        for (int u = 0; u < 3; ++u) {
            const int task = task0 + u * tstride;
            if (task < NTASK) {
                const int e = task / NC4, c = (task - e * NC4) * 4, b64 = e >> 1, last = e & 1, row = b64 * 64 + (last ? 63 : 0), sq = row & (S - 1);
                const bool valid = last ? (sq != S - 1) : (sq != 0);
                const int en = valid ? (last ? e + 1 : e - 1) : e;
                gc[u] = *(const f32x4*)(EP + (size_t)e * DFF + c); vv[u] = *(const f32x4*)(EV + (size_t)e * DFF + c);
                nb[u] = *(const f32x4*)(ER + (size_t)en * DFF + c);
                wv[u] = *(const f32x4*)(cw + (last ? 2 * DFF : 0) + c);
                if (!valid) wv[u] = (f32x4){0.f, 0.f, 0.f, 0.f};
                rowc[u] = row; cc[u] = c;
            }
        }
#pragma unroll
        for (int u = 0; u < 3; ++u) {
            const int task = task0 + u * tstride;
            if (task < NTASK) {
                const f32x4 g = gc[u] + wv[u] * nb[u], v = vv[u];
                u32x2 o;
                o[0] = pack2(silu_mul(g[0], v[0]), silu_mul(g[1], v[1]));
                o[1] = pack2(silu_mul(g[2], v[2]), silu_mul(g[3], v[3]));
                *(u32x2*)(ACT + (size_t)rowc[u] * DFF + cc[u]) = o;
            }
        }
    }
}

DI void swa_prep_phase(const Params& p) {
    unsigned char* const ws = wsp(p);
    const int bid = opaque_bid();
    const bf16_t* QKV = (const bf16_t*)(ws + OFF_QKV32);
    bf16_t* QS = (bf16_t*)(ws + OFF_QS); bf16_t* KS = (bf16_t*)(ws + OFF_KS); bf16_t* VTS = (bf16_t*)(ws + OFF_VTS);
    const int tid = opaque_tid(), wid = tid >> 6, lane = tid & 63;
    const float qsc = 0.125f * LOG2E;
    const int tstep = gridDim.x * 8;
    for (int t0 = bid * 8 + wid; t0 < T; t0 += 2 * tstep)
      {
        u32x2 wl[2][9];
#pragma unroll
        for (int q2 = 0; q2 < 2; ++q2) { const int tq = t0 + q2 * tstep; if (tq < T) {
#pragma unroll
            for (int it = 0; it < 9; ++it) wl[q2][it] = *(const u32x2*)(QKV + (size_t)tq * 2560 + it * 256 + lane * 4); } }
#pragma unroll
      for (int q2 = 0; q2 < 2; ++q2) { const int t = t0 + q2 * tstep; if (t < T) {
        const int b = t / S, s = t - b * S;
#pragma unroll
        for (int it = 0; it < 9; ++it) {
            const int col = it * 256 + lane * 4;
            const u32x2 wv = wl[q2][it]; const f32x4 v = {bflo(wv[0]), bfhi(wv[0]), bflo(wv[1]), bfhi(wv[1])};
            float ss = v[0] * v[0] + v[1] * v[1] + v[2] * v[2] + v[3] * v[3];
            ss = sum16(ss);
            const float rs = rsqrtf(ss * (1.0f / 64.f) + EPS);
            const int d = col & 63;
            if (it < 8) { const f32x4 g = *(const f32x4*)(p.swa_q_gain + d); const float f = rs * qsc;
                u32x2 o; o[0] = pack2(v[0] * f * g[0], v[1] * f * g[1]); o[1] = pack2(v[2] * f * g[2], v[3] * f * g[3]);
                *(u32x2*)(QS + (size_t)t * 2048 + col) = o; }
            else { const f32x4 g = *(const f32x4*)(p.swa_k_gain + d); const int kvh = (col - 2048) >> 6;
                u32x2 o; o[0] = pack2(v[0] * rs * g[0], v[1] * rs * g[1]); o[1] = pack2(v[2] * rs * g[2], v[3] * rs * g[3]);
                *(u32x2*)(KS + ((size_t)(b * 4 + kvh) * S + s) * 64 + d) = o; }
        }
      } }
      }
    for (int ch = bid; ch < T / 64; ch += gridDim.x) {
        const int c = tid & 255, kvh = c >> 6, d = c & 63, tq = tid >> 8;
#pragma unroll
        for (int gi = 0; gi < 4; ++gi) {
            const int t0 = ch * 64 + (tq + 2 * gi) * 8, b = t0 / S, s0 = t0 - b * S;
            unsigned v[8];
#pragma unroll
            for (int e = 0; e < 8; ++e) v[e] = QKV[(size_t)(t0 + e) * 2560 + 2304 + c];
            u32x4 o; o[0] = v[0] | (v[1] << 16); o[1] = v[2] | (v[3] << 16); o[2] = v[4] | (v[5] << 16); o[3] = v[6] | (v[7] << 16);
            *(u32x4*)(VTS + ((size_t)(b * 4 + kvh) * 64 + d) * S + s0) = o;
        }
    }
}

template <int NDB, int VSTR>
DI void softmax_pv(const f32x16& sacc, float& m, float& l, f32x16 (&oacc)[NDB], LAS const unsigned char* vptr) {
    float mx = sacc[0];
#pragma unroll
    for (int i = 1; i < 16; ++i) mx = fmaxf(mx, sacc[i]);
    mx = xmax32(mx);
    if (__any(mx > m + 8.0f)) {
        const float mn = fmaxf(m, mx), alpha = fast_exp2(m - mn);
        l *= alpha; m = mn;
#pragma unroll
        for (int db = 0; db < NDB; ++db)
#pragma unroll
            for (int i = 0; i < 16; ++i) oacc[db][i] *= alpha;
    }
    float pv[16], ls = 0.f;
#pragma unroll
    for (int i = 0; i < 16; ++i) { pv[i] = fast_exp2(sacc[i] - m); ls += pv[i]; }
    l += ls;
#pragma unroll
    for (int s2 = 0; s2 < 2; ++s2) {
        u32x4 pw;
#pragma unroll
        for (int q = 0; q < 4; ++q) pw[q] = pack2(pv[8 * s2 + 2 * q], pv[8 * s2 + 2 * q + 1]);
        const bf16x8 pf = __builtin_bit_cast(bf16x8, pw);
#pragma unroll
        for (int db = 0; db < NDB; ++db) {
            const bf16x8 vf = *(LAS const bf16x8*)(vptr + db * 32 * VSTR + s2 * 32);
            oacc[db] = __builtin_amdgcn_mfma_f32_32x32x16_bf16(vf, pf, oacc[db], 0, 0, 0);
        }
    }
}

template <int NDB, int VSTR>
DI void load_vfrags(bf16x8 (&vf)[2][NDB], LAS const unsigned char* vptr) {
#pragma unroll
    for (int s2 = 0; s2 < 2; ++s2)
#pragma unroll
        for (int db = 0; db < NDB; ++db) {
            vf[s2][db] = *(LAS const bf16x8*)(vptr + db * 32 * VSTR + s2 * 32);
        }
}
template <int NDB>
DI void softmax_only(f32x16& sacc, float& m, float& l, f32x16 (&oacc)[NDB], bf16x8 (&pf)[2]) {
    float mx = sacc[0];
#pragma unroll
    for (int i = 1; i < 16; ++i) mx = fmaxf(mx, sacc[i]);
    mx = xmax32(mx);
    if (__any(mx > 8.0f)) {
        const float d = fmaxf(mx, 0.f), alpha = fast_exp2(-d);
        l *= alpha; m += d;
#pragma unroll
        for (int i = 0; i < 16; ++i) sacc[i] -= d;
#pragma unroll
        for (int db = 0; db < NDB; ++db)
#pragma unroll
            for (int i = 0; i < 16; ++i) oacc[db][i] *= alpha;
    }
    float pv[16], ls = 0.f;
#pragma unroll
    for (int i = 0; i < 16; ++i) { pv[i] = fast_exp2(sacc[i]); ls += pv[i]; }
    l += ls;
#pragma unroll
    for (int s2 = 0; s2 < 2; ++s2) {
        u32x4 pw;
#pragma unroll
        for (int q = 0; q < 4; ++q) pw[q] = pack2(pv[8 * s2 + 2 * q], pv[8 * s2 + 2 * q + 1]);
        pf[s2] = __builtin_bit_cast(bf16x8, pw);
    }
}

DI void swa_attn_phase(const Params& p, LAS unsigned char* lds) {
    unsigned char* const ws = wsp(p);
    const int bid = opaque_bid();
    constexpr int KSTR = 144, VSTR = 592, VOFF = 288 * KSTR;
    const bf16_t* QS = (const bf16_t*)(ws + OFF_QS); const bf16_t* KS = (const bf16_t*)(ws + OFF_KS); const bf16_t* VTS = (const bf16_t*)(ws + OFF_VTS);
    bf16_t* O = (bf16_t*)(ws + OFF_H);
    const int tid = opaque_tid(), wid = tid >> 6, lane = tid & 63, r = lane & 31, h = lane >> 5;
    for (int it0 = bid; it0 < 2048; it0 += gridDim.x) {
        const int item = (gridDim.x == 256) ? (((it0 >> 8) * 8 + (it0 & 7)) * 32 + ((it0 & 255) >> 3)) : it0;
        const int b = item >> 9, kvh = (item >> 7) & 3, qb = item & 127, q0 = qb * 32, kstart = q0 - 128;
        const bf16_t* Kg = KS + (size_t)(b * 4 + kvh) * S * 64; const bf16_t* Vg = VTS + (size_t)(b * 4 + kvh) * 64 * S;
        for (int c = tid; c < 2304; c += 512) { const int row = c >> 3, cc = c & 7, key = kstart + row;
            if (key >= 0 && key < S) *(LAS u32x4*)(lds + row * KSTR + cc * 16) = *(const u32x4*)(Kg + (size_t)key * 64 + cc * 8); }
        for (int c = tid; c < 2304; c += 512) { const int row = c / 36, cc = c - row * 36, key0 = kstart + cc * 8;
            if (key0 >= 0 && key0 < S) { const u32x4 v = *(const u32x4*)(Vg + (size_t)row * S + key0);
                LAS u32x2* dp = (LAS u32x2*)(lds + VOFF + row * VSTR + (cc >> 1) * 32 + (cc & 1) * 8); dp[0] = (u32x2){v[0], v[1]}; dp[2] = (u32x2){v[2], v[3]}; } }
        __syncthreads();
        const int hq = kvh * 8 + wid;
        const float slope2 = exp2f(-(float)(hq + 1) * 0.25f) * LOG2E, sink2 = p.swa_sinks[hq] * LOG2E;
        const bf16_t* Qp = QS + (size_t)(b * S + q0 + r) * 2048 + hq * 64 + 8 * h;
        bf16x8 qf[4];
#pragma unroll
        for (int ks = 0; ks < 4; ++ks) qf[ks] = *(const bf16x8*)(Qp + 16 * ks);
        const int qi = q0 + r, pq = p.positions[qi];
        float m = sink2, l = 0.f;
        f32x16 oacc[2];
#pragma unroll
        for (int db = 0; db < 2; ++db)
#pragma unroll
            for (int i = 0; i < 16; ++i) oacc[db][i] = 0.f;
        for (int blk = 0; blk < 9; ++blk) {
            const int k0 = kstart + blk * 32;
            if (k0 < 0 || k0 >= S) continue;
            f32x16 sacc;
#pragma unroll
            for (int i = 0; i < 16; ++i) sacc[i] = 0.f;
#pragma unroll
            for (int ks = 0; ks < 4; ++ks) { const bf16x8 a = *(LAS const bf16x8*)(lds + (blk * 32 + r) * KSTR + ks * 32 + h * 16);
                sacc = __builtin_amdgcn_mfma_f32_32x32x16_bf16(a, qf[ks], sacc, 0, 0, 0); }
#pragma unroll
            for (int i = 0; i < 16; ++i) { const int key = k0 + (i & 3) + 8 * (i >> 2) + 4 * h;
                const int dk = qi - key, dp = pq - p.positions[key];
                const float sv = sacc[i] - slope2 * (float)(dp < 0 ? -dp : dp);
                sacc[i] = ((dk < 0 ? -dk : dk) <= 128) ? sv : -INFINITY; }
            softmax_pv<2, VSTR>(sacc, m, l, oacc, lds + VOFF + r * VSTR + blk * 64 + h * 16);
        }
        const float lt = xsum32(l) + fast_exp2(sink2 - m), inv = 1.0f / lt;
        bf16_t* Op = O + (size_t)(b * S + qi) * 2048 + hq * 64 + 4 * h;
#pragma unroll
        for (int db = 0; db < 2; ++db)
#pragma unroll
            for (int g = 0; g < 4; ++g) { u32x2 o; o[0] = pack2(oacc[db][4 * g] * inv, oacc[db][4 * g + 1] * inv); o[1] = pack2(oacc[db][4 * g + 2] * inv, oacc[db][4 * g + 3] * inv);
                *(u32x2*)(Op + db * 32 + 8 * g) = o; }
        __syncthreads();
    }
}

DI void mla_prep1_phase(const Params& p) {
    unsigned char* const ws = wsp(p);
    const int bid = opaque_bid();
    const bf16_t* D32 = (const bf16_t*)(ws + OFF_D32);
    bf16_t* CQ = (bf16_t*)(ws + OFF_CQ); bf16_t* CKV = (bf16_t*)(ws + OFF_CKV); bf16_t* KPE = (bf16_t*)(ws + OFF_KPE);
    const float* ct = (const float*)(ws + OFF_ROPE); const float* st = ct + S * 32;
    const int tid = opaque_tid(), wid = tid >> 6, lane = tid & 63;
    const int tstep = gridDim.x * 8;
    for (int t0 = bid * 8 + wid; t0 < T; t0 += 2 * tstep)
      {
        u32x2 wl[2][4]; unsigned short kx[2];
#pragma unroll
        for (int q2 = 0; q2 < 2; ++q2) { const int tq = t0 + q2 * tstep; if (tq < T) { const bf16_t* rw = D32 + (size_t)tq * 1280;
#pragma unroll
            for (int part = 0; part < 2; ++part) { wl[q2][2 * part] = *(const u32x2*)(rw + part * 512 + lane * 4); wl[q2][2 * part + 1] = *(const u32x2*)(rw + part * 512 + 256 + lane * 4); }
            kx[q2] = rw[1024 + lane]; } }
#pragma unroll
      for (int q2 = 0; q2 < 2; ++q2) { const int t = t0 + q2 * tstep; if (t < T) {
        const int s = t & (S - 1);
#pragma unroll
        for (int part = 0; part < 2; ++part) {
            const u32x2 wa = wl[q2][2 * part], wc2 = wl[q2][2 * part + 1];
            const f32x4 a = {bflo(wa[0]), bfhi(wa[0]), bflo(wa[1]), bfhi(wa[1])}, c = {bflo(wc2[0]), bfhi(wc2[0]), bflo(wc2[1]), bfhi(wc2[1])};
            float ss = a[0] * a[0] + a[1] * a[1] + a[2] * a[2] + a[3] * a[3] + c[0] * c[0] + c[1] * c[1] + c[2] * c[2] + c[3] * c[3];
            ss = wave_sum(ss);
            const float rs = rsqrtf(ss * (1.0f / 512.f) + EPS);
            const float* gp = part ? p.mla_kv_a_gain : p.mla_q_a_gain; bf16_t* dst = (part ? CKV : CQ) + (size_t)t * 512;
            const f32x4 g0 = *(const f32x4*)(gp + lane * 4), g1 = *(const f32x4*)(gp + 256 + lane * 4);
            u32x2 o0, o1; o0[0] = pack2(a[0] * rs * g0[0], a[1] * rs * g0[1]); o0[1] = pack2(a[2] * rs * g0[2], a[3] * rs * g0[3]);
            o1[0] = pack2(c[0] * rs * g1[0], c[1] * rs * g1[1]); o1[1] = pack2(c[2] * rs * g1[2], c[3] * rs * g1[3]);
            *(u32x2*)(dst + lane * 4) = o0; *(u32x2*)(dst + 256 + lane * 4) = o1;
        }
        const float x = bf2f(kx[q2]);
        const float ss = wave_sum(x * x);
        const float xn = x * rsqrtf(ss * (1.0f / 64.f) + EPS) * p.mla_kr_gain[lane];
        const float pr = __shfl_xor(xn, 32);
        const float cc = ct[s * 32 + (lane & 31)], sn = st[s * 32 + (lane & 31)];
        const float o = lane < 32 ? xn * cc - pr * sn : xn * cc + pr * sn;
        KPE[(size_t)t * 64 + lane] = f2bf(o);
      } }
      }
}

DI void mla_prep2_phase(const Params& p) {
    unsigned char* const ws = wsp(p);
    const int bid = opaque_bid();
    const bf16_t* Q32 = (const bf16_t*)(ws + OFF_Q32); const bf16_t* KV32 = (const bf16_t*)(ws + OFF_KV32); const bf16_t* KPE = (const bf16_t*)(ws + OFF_KPE);
    bf16_t* QN = (bf16_t*)(ws + OFF_QN); bf16_t* KC = (bf16_t*)(ws + OFF_KC); bf16_t* VT = (bf16_t*)(ws + OFF_VT);
    const float* ct = (const float*)(ws + OFF_ROPE); const float* st = ct + S * 32;
    const int tid = opaque_tid(), wid = tid >> 6, lane = tid & 63;
    const float qsc = 0.07216878364870322f * LOG2E;
    const int j = lane & 15, hsub = lane >> 4;
    float gqn[8], gkn[8], gqr[4];
#pragma unroll
    for (int e = 0; e < 8; ++e) { gqn[e] = p.mla_qn_gain[8 * j + e]; gkn[e] = p.mla_kn_gain[8 * j + e]; }
#pragma unroll
    for (int e = 0; e < 4; ++e) gqr[e] = p.mla_qr_gain[4 * j + e];
    const int tstride = gridDim.x * 8;
    for (int task0 = bid * 8 + wid; task0 < T * 4; task0 += 4 * tstride) {
        u32x4 wq4[4], wk4[4]; u32x2 wp4[4], kp4[4];
#pragma unroll
        for (int u = 0; u < 4; ++u) {
            const int task = task0 + u * tstride;
            if (task < T * 4) {
                const int t = task >> 2, hh = (task & 3) * 4 + hsub;
                const bf16_t* qrow = Q32 + (size_t)t * 3072 + hh * 192; const bf16_t* kvrow = KV32 + (size_t)t * 4096 + hh * 256;
                wq4[u] = *(const u32x4*)(qrow + 8 * j); wk4[u] = *(const u32x4*)(kvrow + 8 * j);
                wp4[u] = *(const u32x2*)(qrow + 128 + 4 * j); kp4[u] = *(const u32x2*)(KPE + (size_t)t * 64 + 4 * j);
            }
        }
#pragma unroll
        for (int u = 0; u < 4; ++u) {
            const int task = task0 + u * tstride;
            if (task < T * 4) {
                const int t = task >> 2, hh = (task & 3) * 4 + hsub, b = t / S, s = t - b * S;
                const size_t ob = ((size_t)(b * 16 + hh) * S + s) * 192;
                const u32x4 wq = wq4[u], wk = wk4[u]; const u32x2 wp = wp4[u], kp = kp4[u];
                float q[8], k[8], x[4];
#pragma unroll
                for (int e = 0; e < 4; ++e) { q[2 * e] = bflo(wq[e]); q[2 * e + 1] = bfhi(wq[e]); k[2 * e] = bflo(wk[e]); k[2 * e + 1] = bfhi(wk[e]); }
                x[0] = bflo(wp[0]); x[1] = bfhi(wp[0]); x[2] = bflo(wp[1]); x[3] = bfhi(wp[1]);
                float sq = 0.f, sk = 0.f, sx = 0.f;
#pragma unroll
                for (int e = 0; e < 8; ++e) { sq += q[e] * q[e]; sk += k[e] * k[e]; }
#pragma unroll
                for (int e = 0; e < 4; ++e) sx += x[e] * x[e];
                sq = sum16(sq); sk = sum16(sk); sx = sum16(sx);
                const float fq = rsqrtf(sq * (1.0f / 128.f) + EPS) * qsc, fk = rsqrtf(sk * (1.0f / 128.f) + EPS), fx = rsqrtf(sx * (1.0f / 64.f) + EPS);
                u32x4 oq, ok;
#pragma unroll
                for (int e = 0; e < 4; ++e) { oq[e] = pack2(q[2 * e] * fq * gqn[2 * e], q[2 * e + 1] * fq * gqn[2 * e + 1]); ok[e] = pack2(k[2 * e] * fk * gkn[2 * e], k[2 * e + 1] * fk * gkn[2 * e + 1]); }
                *(u32x4*)(QN + ob + 8 * j) = oq; *(u32x4*)(KC + ob + 8 * j) = ok;
                float ro[4];
#pragma unroll
                for (int e = 0; e < 4; ++e) { const float xn = x[e] * fx * gqr[e], pr = dppf<0x128>(xn);
                    const int fi = (4 * j + e) & 31; const float cc = ct[s * 32 + fi], sn = st[s * 32 + fi];
                    ro[e] = (j < 8 ? xn * cc - pr * sn : xn * cc + pr * sn) * qsc; }
                u32x2 op; op[0] = pack2(ro[0], ro[1]); op[1] = pack2(ro[2], ro[3]);
                *(u32x2*)(QN + ob + 128 + 4 * j) = op;
                *(u32x2*)(KC + ob + 128 + 4 * j) = kp;
            }
        }
    }
    for (int bt = bid; bt < (T / 64) * 16; bt += gridDim.x) {
        const int ch = bt >> 4, hh = bt & 15, dv = tid & 127, tq = tid >> 7;
#pragma unroll
        for (int gi = 0; gi < 2; ++gi) {
            const int t0 = ch * 64 + (tq + 4 * gi) * 8, b = t0 / S, s0 = t0 - b * S;
            unsigned v[8];
#pragma unroll
            for (int e = 0; e < 8; ++e) v[e] = KV32[(size_t)(t0 + e) * 4096 + hh * 256 + 128 + dv];
            u32x4 o; o[0] = v[0] | (v[1] << 16); o[1] = v[2] | (v[3] << 16); o[2] = v[4] | (v[5] << 16); o[3] = v[6] | (v[7] << 16);
            *(u32x4*)(VT + ((size_t)(b * 16 + hh) * 128 + dv) * S + s0) = o;
        }
    }
}

DI void mla_attn_phase(const Params& p, LAS unsigned char* lds) {
    unsigned char* const ws = wsp(p);
    const int bid = opaque_bid();
    constexpr int KSTR = 400, VSTR = 144, KBUF = 64 * KSTR, VBUF = 128 * VSTR, BUF = KBUF + VBUF, NT = S / 64;
    const bf16_t* QN = (const bf16_t*)(ws + OFF_QN); const bf16_t* KC = (const bf16_t*)(ws + OFF_KC); const bf16_t* VT = (const bf16_t*)(ws + OFF_VT);
    bf16_t* O = (bf16_t*)(ws + OFF_H);
    const int tid = opaque_tid(), wid = tid >> 6, lane = tid & 63, r = lane & 31, h = lane >> 5;
    unsigned klds[3], vlds[2], vgo[2];
#pragma unroll
    for (int i = 0; i < 3; ++i) { const int c = tid + 512 * i, kr = c / 24; klds[i] = (unsigned)(kr * KSTR + (c - kr * 24) * 16); }
#pragma unroll
    for (int i = 0; i < 2; ++i) { const int c = tid + 512 * i, vr = c >> 3, vc = c & 7; vlds[i] = (unsigned)(KBUF + vr * VSTR + (vc >> 1) * 32 + (vc & 1) * 8); vgo[i] = (unsigned)((vr * S + vc * 8) * 2); }
    const unsigned kgo = (unsigned)tid * 16u;
    for (int it0 = bid; it0 < 1024; it0 += gridDim.x) {
        const int item = (gridDim.x == 256) ? (((it0 >> 8) * 8 + (it0 & 7)) * 32 + ((it0 & 255) >> 3)) : it0;
        const int bh = item >> 4, qb = item & 15, b = bh >> 4, hh = bh & 15, q0 = qb * 256 + wid * 32;
        const char* Kg = (const char*)(KC + (size_t)bh * S * 192); const char* Vg = (const char*)(VT + (size_t)bh * 128 * S);
        const bf16_t* Qp = QN + ((size_t)bh * S + q0 + r) * 192 + 8 * h;
        bf16x8 qf[12];
#pragma unroll
        for (int ks = 0; ks < 12; ++ks) qf[ks] = *(const bf16x8*)(Qp + 16 * ks);
        u32x4 kreg[3], vreg[2];
#define MLA_LOAD(k0) do { const char* kt_ = Kg + (size_t)(k0) * 384; const char* vt_ = Vg + (size_t)(k0) * 2; \
                          _Pragma("unroll") for (int i = 0; i < 3; ++i) kreg[i] = *(const u32x4*)(kt_ + kgo + i * 8192); \
                          _Pragma("unroll") for (int i = 0; i < 2; ++i) vreg[i] = *(const u32x4*)(vt_ + vgo[i]); } while (0)
#define MLA_STORE(bufp) do { _Pragma("unroll") for (int i = 0; i < 3; ++i) *(LAS u32x4*)((bufp) + klds[i]) = kreg[i]; \
                             _Pragma("unroll") for (int i = 0; i < 2; ++i) { LAS u32x2* dp = (LAS u32x2*)((bufp) + vlds[i]); \
                                 dp[0] = (u32x2){vreg[i][0], vreg[i][1]}; dp[2] = (u32x2){vreg[i][2], vreg[i][3]}; } } while (0)
        MLA_LOAD(0); MLA_STORE(lds);
        __syncthreads();
        float m = 0.f, l = 0.f;
        f32x16 oacc[4];
#pragma unroll
        for (int db = 0; db < 4; ++db)
#pragma unroll
            for (int i = 0; i < 16; ++i) oacc[db][i] = 0.f;
        for (int t = 0; t < NT; ++t) {
            if (t + 1 < NT) MLA_LOAD((t + 1) * 64);
            LAS unsigned char* kb = lds + (t & 1) * BUF;
#pragma unroll
            for (int blk = 0; blk < 2; ++blk) {
                bf16x8 kf[12];
                LAS const unsigned char* kp = kb + (blk * 32 + r) * KSTR + h * 16;
#pragma unroll
                for (int ks = 0; ks < 4; ++ks) kf[ks] = *(LAS const bf16x8*)(kp + ks * 32);
                f32x16 sacc;
#pragma unroll
                for (int i = 0; i < 16; ++i) sacc[i] = -m;
#pragma unroll
                for (int kg = 0; kg < 3; ++kg) {
                    if (kg < 2) {
#pragma unroll
                        for (int ks = 0; ks < 4; ++ks) kf[4 * (kg + 1) + ks] = *(LAS const bf16x8*)(kp + (4 * (kg + 1) + ks) * 32);
                    }
#pragma unroll
                    for (int ks = 0; ks < 4; ++ks) sacc = __builtin_amdgcn_mfma_f32_32x32x16_bf16(kf[4 * kg + ks], qf[4 * kg + ks], sacc, 0, 0, 0);
                }
                bf16x8 vf[2][4], pf[2];
                load_vfrags<4, VSTR>(vf, kb + KBUF + r * VSTR + blk * 64 + h * 16);
                softmax_only<4>(sacc, m, l, oacc, pf);
#pragma unroll
                for (int s2 = 0; s2 < 2; ++s2)
#pragma unroll
                    for (int db = 0; db < 4; ++db) oacc[db] = __builtin_amdgcn_mfma_f32_32x32x16_bf16(vf[s2][db], pf[s2], oacc[db], 0, 0, 0);
            }
            if (t + 1 < NT) MLA_STORE(lds + ((t + 1) & 1) * BUF);
            __syncthreads();
        }
#undef MLA_LOAD
#undef MLA_STORE
        const float lt = xsum32(l), inv = 1.0f / lt;
        bf16_t* Op = O + (size_t)(b * S + q0 + r) * 2048 + hh * 128 + 4 * h;
#pragma unroll
        for (int db = 0; db < 4; ++db)
#pragma unroll
            for (int g = 0; g < 4; ++g) { u32x2 o; o[0] = pack2(oacc[db][4 * g] * inv, oacc[db][4 * g + 1] * inv); o[1] = pack2(oacc[db][4 * g + 2] * inv, oacc[db][4 * g + 3] * inv);
                *(u32x2*)(Op + db * 32 + 8 * g) = o; }
    }
}

constexpr int BM = 256, BK = 64, HALF = 128, HTB = HALF * BK * 2, NXCD = 8, WGM = 8;
DI int lds_byte(int r, int c) { const int st = (r >> 4) * 2 + (c >> 5), rr = r & 15, cc = c & 31, ob = rr * 64 + cc * 2; return st * 1024 + (ob ^ (((ob >> 9) & 1) << 5)); }
DI int perm32(int rho) { const int n = rho >> 4, i = rho & 15; return 8 * (i >> 2) + 4 * n + (i & 3); }
DI void stage_rc(int b, int& R, int& C) { const int st = b / 1024, sb = b % 1024, swz = sb ^ (((sb >> 9) & 1) << 5); R = (st >> 1) * 16 + swz / 64; C = (st & 1) * 32 + (swz % 64) / 2; }
struct Unit { int pm, pn; };
DI bool sched_next(int i, int nM, int nN, int G, int c, Unit& u) {
    const int nwg = nM * nN; const long L = (long)i * G + c; if (L >= nwg) return false;
    int wgid = (int)L; { const int q = nwg / NXCD, r = nwg % NXCD, xcd = wgid % NXCD, off = wgid / NXCD; wgid = (xcd < r ? xcd * (q + 1) : r * (q + 1) + (xcd - r) * q) + off; }
    const int nig = WGM * nN, gid = wgid / nig, fm = gid * WGM, gsz = (nM - fm) < WGM ? (nM - fm) : WGM;
    u.pm = fm + ((wgid % nig) % gsz); u.pn = (wgid % nig) / gsz; return true;
}

struct EpiF32 {
    static constexpr bool PERM = false;
    float* C; int ldc; float* C2; int ldc2; int split;
    DI void operator()(const f32x4 (&acc)[2][2][4][2], const Unit& u, int wr, int wc, int fr, int fq) const {
        float* base = C; int ld = ldc, pn = u.pn; if (pn >= split) { base = C2; ld = ldc2; pn -= split; }
        const int row0 = u.pm * BM + wr * 64 + fr, col0 = pn * BM + wc * 32 + 4 * fq;
#pragma unroll
        for (int ai = 0; ai < 2; ++ai)
#pragma unroll
            for (int m = 0; m < 4; ++m) { float* rowp = base + (size_t)(row0 + ai * HALF + m * 16) * ld + col0;
#pragma unroll
                for (int bj = 0; bj < 2; ++bj)
#pragma unroll
                    for (int n = 0; n < 2; ++n) *(f32x4*)(rowp + bj * HALF + n * 16) = acc[ai][bj][m][n]; }
    }
};
struct EpiBf16 {
    static constexpr bool PERM = true;
    bf16_t* O1; int ldc1; bf16_t* O2; int ldc2; int split;
    DI void operator()(const f32x4 (&acc)[2][2][4][2], const Unit& u, int wr, int wc, int fr, int fq) const {
        bf16_t* O = O1; int ldc = ldc1, pn = u.pn; if (pn >= split) { O = O2; ldc = ldc2; pn -= split; }
        const int row0 = u.pm * BM + wr * 64 + fr, col0 = pn * BM + wc * 32 + 8 * fq;
#pragma unroll
        for (int ai = 0; ai < 2; ++ai)
#pragma unroll
            for (int m = 0; m < 4; ++m) { bf16_t* rowp = O + (size_t)(row0 + ai * HALF + m * 16) * ldc + col0;
#pragma unroll
                for (int bj = 0; bj < 2; ++bj) { const f32x4 v0 = acc[ai][bj][m][0], v1 = acc[ai][bj][m][1];
                    u32x4 o; o[0] = pack2(v0[0], v0[1]); o[1] = pack2(v0[2], v0[3]); o[2] = pack2(v1[0], v1[1]); o[3] = pack2(v1[2], v1[3]);
                    *(u32x4*)(rowp + bj * HALF) = o; } }
    }
};
template <bool IB, bool OB> struct EpiRes {
    static constexpr bool PERM = true;
    const void* Xin; void* Xout; const float* scale;
    DI void operator()(const f32x4 (&acc)[2][2][4][2], const Unit& u, int wr, int wc, int fr, int fq) const {
        const int row0 = u.pm * BM + wr * 64 + fr, col0 = u.pn * BM + wc * 32 + 8 * fq;
        f32x4 sc[2][2];
#pragma unroll
        for (int bj = 0; bj < 2; ++bj)
#pragma unroll
            for (int n = 0; n < 2; ++n) sc[bj][n] = scale ? *(const f32x4*)(scale + col0 + bj * HALF + 4 * n) : (f32x4){1.f, 1.f, 1.f, 1.f};
#pragma unroll
        for (int ai = 0; ai < 2; ++ai)
#pragma unroll
            for (int m = 0; m < 4; ++m) { const size_t ro = (size_t)(row0 + ai * HALF + m * 16) * D + col0;
#pragma unroll
                for (int bj = 0; bj < 2; ++bj) {
                    f32x4 x0, x1;
                    if constexpr (IB) { const u32x4 w = *(const u32x4*)((const bf16_t*)Xin + ro + bj * HALF);
                        x0 = (f32x4){bflo(w[0]), bfhi(w[0]), bflo(w[1]), bfhi(w[1])}; x1 = (f32x4){bflo(w[2]), bfhi(w[2]), bflo(w[3]), bfhi(w[3])}; }
                    else { x0 = *(const f32x4*)((const float*)Xin + ro + bj * HALF); x1 = *(const f32x4*)((const float*)Xin + ro + bj * HALF + 4); }
                    x0 += acc[ai][bj][m][0] * sc[bj][0]; x1 += acc[ai][bj][m][1] * sc[bj][1];
                    if constexpr (OB) { u32x4 o; o[0] = pack2(x0[0], x0[1]); o[1] = pack2(x0[2], x0[3]); o[2] = pack2(x1[0], x1[1]); o[3] = pack2(x1[2], x1[3]);
                        *(u32x4*)((bf16_t*)Xout + ro + bj * HALF) = o; }
                    else { *(f32x4*)((float*)Xout + ro + bj * HALF) = x0; *(f32x4*)((float*)Xout + ro + bj * HALF + 4) = x1; } } }
    }
};
struct EpiGlu {
    static constexpr bool PERM = true;
    const float* cw; const float* cb; bf16_t* ACT; float* EP; float* ER; float* EV;
    DI void operator()(const f32x4 (&acc)[2][2][4][2], const Unit& u, int wr, int wc, int fr, int fq) const {
        const int row0 = u.pm * BM + wr * 64 + fr, ch0 = u.pn * 128 + wc * 32 + 8 * fq;
        f32x4 w0[2], w1[2], w2[2], bb[2];
#pragma unroll
        for (int n = 0; n < 2; ++n) { w0[n] = *(const f32x4*)(cw + ch0 + 4 * n); w1[n] = *(const f32x4*)(cw + DFF + ch0 + 4 * n); w2[n] = *(const f32x4*)(cw + 2 * DFF + ch0 + 4 * n); bb[n] = *(const f32x4*)(cb + ch0 + 4 * n); }
#pragma unroll
        for (int ai = 0; ai < 2; ++ai)
#pragma unroll
            for (int m = 0; m < 4; ++m) {
                const bool efirst = (m == 0) && (fr == 0), elast = (m == 3) && (fr == 15);
                const int row = row0 + ai * HALF + m * 16;
                f32x4 gc[2];
#pragma unroll
                for (int n = 0; n < 2; ++n) {
                    const f32x4 g = acc[ai][0][m][n];
                    const f32x4 gprev = acc[ai][0][m > 0 ? m - 1 : 0][n], gnext = acc[ai][0][m < 3 ? m + 1 : 3][n];
                    f32x4 up, dn;
#pragma unroll
                    for (int e = 0; e < 4; ++e) {
                        const float pu = (m > 0 && fr == 15) ? gprev[e] : g[e];
                        const float pd = (m < 3 && fr == 0) ? gnext[e] : g[e];
                        up[e] = dpp_ror1(pu); dn[e] = dpp_ror15(pd);
                    }
                    if (efirst) up = (f32x4){0.f, 0.f, 0.f, 0.f};
                    if (elast) dn = (f32x4){0.f, 0.f, 0.f, 0.f};
                    gc[n] = w0[n] * up + w1[n] * g + w2[n] * dn + bb[n];
                }
                if (efirst || elast) {
                    const size_t eo = (size_t)((row >> 6) * 2 + (elast ? 1 : 0)) * DFF + ch0;
#pragma unroll
                    for (int n = 0; n < 2; ++n) { *(f32x4*)(EP + eo + 4 * n) = gc[n]; *(f32x4*)(ER + eo + 4 * n) = acc[ai][0][m][n]; *(f32x4*)(EV + eo + 4 * n) = acc[ai][1][m][n]; }
                } else {
                    const f32x4 v0 = acc[ai][1][m][0], v1 = acc[ai][1][m][1];
                    u32x4 o;
                    o[0] = pack2(silu_mul(gc[0][0], v0[0]), silu_mul(gc[0][1], v0[1])); o[1] = pack2(silu_mul(gc[0][2], v0[2]), silu_mul(gc[0][3], v0[3]));
                    o[2] = pack2(silu_mul(gc[1][0], v1[0]), silu_mul(gc[1][1], v1[1])); o[3] = pack2(silu_mul(gc[1][2], v1[2]), silu_mul(gc[1][3], v1[3]));
                    *(u32x4*)(ACT + (size_t)row * DFF + ch0) = o;
                }
            }
    }
};
struct MapPlain { const bf16_t* A; const bf16_t* B; int lda, ldb;
    DI const char* a(const Unit& u) const { return (const char*)(A + (size_t)u.pm * BM * lda); }
    DI const char* b(const Unit& u) const { return (const char*)(B + (size_t)u.pn * BM * ldb); } };
struct MapPool { const bf16_t* A; const bf16_t* B;
    DI const char* a(const Unit& u) const { return (const char*)(A + (size_t)u.pm * BM * 2048 + (u.pn >> 1) * 512); }
    DI const char* b(const Unit& u) const { return (const char*)(B + ((size_t)(u.pn >> 1) * 512 + (u.pn & 1) * 256) * 512); } };
struct MapUqkv { const bf16_t* A1; const bf16_t* A2; const bf16_t* B1; const bf16_t* B2;
    DI const char* a(const Unit& u) const { return (const char*)((u.pn < 12 ? A1 : A2) + (size_t)u.pm * BM * 512); }
    DI const char* b(const Unit& u) const { return (const char*)(u.pn < 12 ? B1 + (size_t)u.pn * BM * 512 : B2 + (size_t)(u.pn - 12) * BM * 512); } };

template <class Map, class Epi>
DI void gemm_phase(LAS unsigned char* lds, const Map& MP, const Epi& E, const int nM, const int nN, const int K, const int lda, const int ldb) {
    const int tid = opaque_tid(), wid = __builtin_amdgcn_readfirstlane(tid >> 6), lane = tid & 63, wr = wid >> 2, wc = wid & 3, fr = lane & 15, fq = lane >> 4;
    const int nt = K / BK, G = gridDim.x, cblk = opaque_bid();
    unsigned voffA[2], voffB[2];
#pragma unroll
    for (int i = 0; i < 2; ++i) { int R, C; stage_rc(tid * 16 + i * 8192, R, C); const int Rb = Epi::PERM ? ((R & ~31) + perm32(R & 31)) : R;
        voffA[i] = (unsigned)(R * lda + C) * 2u; voffB[i] = (unsigned)(Rb * ldb + C) * 2u; }
    const size_t kstep = (size_t)(BK * 2);
    const size_t hstepA = (size_t)HALF * lda * 2, hstepB = (size_t)HALF * ldb * 2;
    const unsigned ldsw = (unsigned)wid * 1024u;
    const int aoff = lds_byte(wr * 64 + fr, fq * 8), boff = lds_byte(wc * 32 + fr, fq * 8);
#define PG8_SA(b, h) (((b) * 2 + (h)) * HTB)
#define PG8_SB(b, h) ((4 + (b) * 2 + (h)) * HTB)
#define PG8_STAGE(bufoff, gbase, voff) do { _Pragma("unroll") for (int _i = 0; _i < 2; ++_i) \
        __builtin_amdgcn_global_load_lds((const unsigned*)((const char*)(gbase) + (voff)[_i]), (LAS unsigned*)(lds + (bufoff) + ldsw + _i * 8192), 16, 0, 0); } while (0)
#define PG8_LDA(dst, b, h) do { _Pragma("unroll") for (int m = 0; m < 4; ++m) _Pragma("unroll") for (int k = 0; k < 2; ++k) dst[m][k] = *(const LAS bf16x8*)(lds + PG8_SA(b, h) + aoff + m * 2048 + k * 1024); } while (0)
#define PG8_LDB(dst, b, h) do { _Pragma("unroll") for (int n = 0; n < 2; ++n) _Pragma("unroll") for (int k = 0; k < 2; ++k) dst[n][k] = *(const LAS bf16x8*)(lds + PG8_SB(b, h) + boff + n * 2048 + k * 1024); } while (0)
#define PG8_MMA(ai, bj, At, Bt) do { __builtin_amdgcn_s_setprio(1); _Pragma("unroll") for (int m = 0; m < 4; ++m) _Pragma("unroll") for (int n = 0; n < 2; ++n) _Pragma("unroll") for (int k = 0; k < 2; ++k) \
        acc[ai][bj][m][n] = __builtin_amdgcn_mfma_f32_16x16x32_bf16(Bt[n][k], At[m][k], acc[ai][bj][m][n], 0, 0, 0); __builtin_amdgcn_s_setprio(0); } while (0)
#define PG8_WAIT_V(n) asm volatile("s_waitcnt vmcnt(" #n ")" ::: "memory")
#define PG8_WAIT_L(n) asm volatile("s_waitcnt lgkmcnt(" #n ")" ::: "memory")
#define PG8_BAR __builtin_amdgcn_s_barrier()
#define PG8_SCHED __builtin_amdgcn_sched_barrier(0)
    Unit cur, nxt; int ui = 0;
    if (!sched_next(0, nM, nN, G, cblk, cur)) return;
    f32x4 acc[2][2][4][2];
#pragma unroll
    for (int a = 0; a < 2; ++a)
#pragma unroll
        for (int b = 0; b < 2; ++b)
#pragma unroll
            for (int m = 0; m < 4; ++m)
#pragma unroll
                for (int n = 0; n < 2; ++n) acc[a][b][m][n] = (f32x4){0.f, 0.f, 0.f, 0.f};
    bf16x8 At[4][2], B0[2][2], B1[2][2];
    const char* cA = MP.a(cur); const char* cB = MP.b(cur);
    PG8_STAGE(PG8_SB(0, 0), cB, voffB); PG8_STAGE(PG8_SA(0, 0), cA, voffA); PG8_STAGE(PG8_SB(0, 1), cB + hstepB, voffB); PG8_STAGE(PG8_SA(0, 1), cA + hstepA, voffA);
    if (wr == 1) PG8_BAR;
    PG8_WAIT_V(4); PG8_BAR;
    PG8_STAGE(PG8_SB(1, 0), cB + kstep, voffB); PG8_STAGE(PG8_SA(1, 0), cA + kstep, voffA); PG8_STAGE(PG8_SB(1, 1), cB + hstepB + kstep, voffB);
    PG8_WAIT_V(6); PG8_BAR;
    for (;;) {
        const bool has_next = sched_next(ui + 1, nM, nN, G, cblk, nxt);
        const char* nA = has_next ? MP.a(nxt) : cA; const char* nB = has_next ? MP.b(nxt) : cB;
        for (int t = 0; t < nt; t += 2) {
            const bool last = (t == nt - 2);
            const char* a1 = cA + (size_t)(t + 1) * kstep;
            const char* a2 = last ? nA : cA + (size_t)(t + 2) * kstep; const char* b2 = last ? nB : cB + (size_t)(t + 2) * kstep;
            const char* a3 = a2 + kstep; const char* b3 = b2 + kstep;
            PG8_LDB(B0, 0, 0); PG8_SCHED; PG8_LDA(At, 0, 0); PG8_STAGE(PG8_SA(1, 1), a1 + hstepA, voffA);
            PG8_WAIT_L(8); PG8_BAR; PG8_WAIT_L(0); PG8_MMA(0, 0, At, B0); PG8_BAR; PG8_SCHED;
            PG8_LDB(B1, 0, 1); PG8_STAGE(PG8_SB(0, 0), b2, voffB);
            PG8_BAR; PG8_WAIT_L(0); PG8_MMA(0, 1, At, B1); PG8_BAR;
            PG8_LDA(At, 0, 1); PG8_STAGE(PG8_SA(0, 0), a2, voffA);
            PG8_BAR; PG8_WAIT_L(0); PG8_MMA(1, 0, At, B0); PG8_BAR; PG8_SCHED;
            PG8_STAGE(PG8_SB(0, 1), b2 + hstepB, voffB);
            PG8_WAIT_V(6); PG8_BAR; PG8_MMA(1, 1, At, B1); PG8_BAR;
            PG8_LDB(B0, 1, 0); PG8_SCHED; PG8_LDA(At, 1, 0); PG8_STAGE(PG8_SA(0, 1), a2 + hstepA, voffA);
            PG8_WAIT_L(8); PG8_BAR; PG8_WAIT_L(0); PG8_MMA(0, 0, At, B0); PG8_BAR; PG8_SCHED;
            PG8_LDB(B1, 1, 1); PG8_STAGE(PG8_SB(1, 0), b3, voffB);
            PG8_BAR; PG8_WAIT_L(0); PG8_MMA(0, 1, At, B1); PG8_BAR;
            PG8_LDA(At, 1, 1); PG8_STAGE(PG8_SA(1, 0), a3, voffA);
            PG8_BAR; PG8_WAIT_L(0); PG8_MMA(1, 0, At, B0); PG8_BAR; PG8_SCHED;
            PG8_STAGE(PG8_SB(1, 1), b3 + hstepB, voffB);
            PG8_WAIT_V(6); PG8_BAR; PG8_MMA(1, 1, At, B1); PG8_BAR;
        }
        { int frr = fr, fqq = fq; asm volatile("" : "+v"(frr), "+v"(fqq)); E(acc, cur, wr, wc, frr, fqq); }
        if (!has_next) break;
#pragma unroll
        for (int a = 0; a < 2; ++a)
#pragma unroll
            for (int b = 0; b < 2; ++b)
#pragma unroll
                for (int m = 0; m < 4; ++m)
#pragma unroll
                    for (int n = 0; n < 2; ++n) acc[a][b][m][n] = (f32x4){0.f, 0.f, 0.f, 0.f};
        cur = nxt; cA = nA; cB = nB; ++ui;
    }
    PG8_WAIT_V(0);
    if (wr == 0) PG8_BAR;
    PG8_BAR;
#undef PG8_SA
#undef PG8_SB
#undef PG8_STAGE
#undef PG8_LDA
#undef PG8_LDB
#undef PG8_MMA
#undef PG8_WAIT_V
#undef PG8_WAIT_L
#undef PG8_BAR
#undef PG8_SCHED
}


#define XB_TMO      128
#define XB_XCNT(j)  (256  + 64 * (j))
#define XB_XSUB(j)  (1280 + 64 * (j))
#define XB_XGEN(j)  (2304 + 64 * (j))
#define XB_TOP      3328
#define XB_TOPGEN   3392
#define XCD_BAR_WORDS 3456
#define XB_SPIN_CAP (1u << 18)
DI unsigned xb_ld(unsigned* p)              { return __hip_atomic_load(p, __ATOMIC_RELAXED, __HIP_MEMORY_SCOPE_AGENT); }
DI unsigned xb_add(unsigned* p, unsigned v) { return __hip_atomic_fetch_add(p, v, __ATOMIC_RELAXED, __HIP_MEMORY_SCOPE_AGENT); }
DI unsigned xb_xcc_id() { return (unsigned)__builtin_amdgcn_s_getreg((3 << 11) | 20) & 0xFu; }
#define XB_SPIN(cond, bar) do { unsigned _sp = 0; while (cond) { __builtin_amdgcn_s_sleep(1); \
    if ((++_sp & 255u) == 0u) { if (xb_ld(&(bar)[XB_TMO])) break; if (_sp > XB_SPIN_CAP) { atomicAdd(&(bar)[XB_TMO], 1u); break; } } } } while (0)
struct XcdBarrier { unsigned* bar; unsigned x; volatile LAS unsigned* st; };
DI XcdBarrier xcd_barrier_post(unsigned* bar, volatile LAS unsigned* st) {
    XcdBarrier b; b.bar = bar; b.x = xb_xcc_id(); b.st = st;
    if (threadIdx.x == 0) (void)xb_add(&bar[XB_XCNT(b.x)], 1u);
    return b;
}
DI void xcd_barrier_complete(unsigned* bar, unsigned x, unsigned& nloc, unsigned& nx) {
    const unsigned G = gridDim.x * gridDim.y * gridDim.z;
    unsigned sum, cnt, mine, sp = 0u;
    for (;;) {
        sum = 0u; cnt = 0u; mine = 0u;
#pragma unroll
        for (unsigned j = 0; j < 16; ++j) { const unsigned c = xb_ld(&bar[XB_XCNT(j)]); sum += c; cnt += (c > 0u) ? 1u : 0u; mine = (j == x) ? c : mine; }
        if (sum == G) break;
        __builtin_amdgcn_s_sleep(1);
        if ((++sp & 255u) == 0u) { if (xb_ld(&bar[XB_TMO])) break; if (sp > XB_SPIN_CAP) { atomicAdd(&bar[XB_TMO], 1u); break; } }
    }
    nloc = mine > 0u ? mine : 1u; nx = cnt > 0u ? cnt : 1u;
}
DI void xcd_barrier(const XcdBarrier& b) {
    asm volatile("s_waitcnt vmcnt(0)" ::: "memory");
    __syncthreads();
    if (threadIdx.x == 0) {
        unsigned* bar = b.bar;
        __builtin_amdgcn_s_waitcnt(0);
        unsigned nloc = b.st[0], nx = b.st[1];
        if (nloc == 0u) { xcd_barrier_complete(bar, b.x, nloc, nx); b.st[0] = nloc; b.st[1] = nx; }
        const unsigned old = xb_add(&bar[XB_XSUB(b.x)], 1u);
        const unsigned gen = old / nloc;
        if (old + 1u == (gen + 1u) * nloc) {
            __builtin_amdgcn_fence(__ATOMIC_RELEASE, "agent");
            asm volatile("s_waitcnt vmcnt(0)" ::: "memory");
            const unsigned og = xb_add(&bar[XB_TOP], 1u);
            const unsigned tg = og / nx;
            if (og + 1u == (tg + 1u) * nx) xb_add(&bar[XB_TOPGEN], 1u);
            else XB_SPIN(xb_ld(&bar[XB_TOPGEN]) == tg, bar);
            __builtin_amdgcn_fence(__ATOMIC_ACQUIRE, "agent");
            xb_add(&bar[XB_XGEN(b.x)], 1u);
            asm volatile("s_waitcnt vmcnt(0)" ::: "memory");
        } else {
            XB_SPIN(xb_ld(&bar[XB_XGEN(b.x)]) == gen, bar);
            __builtin_amdgcn_fence(__ATOMIC_ACQUIRE, "agent");
            asm volatile("s_waitcnt vmcnt(0)" ::: "memory");
        }
    }
    __syncthreads();
}

#define PH(...) do { if (MEGA || phase == idx) { unsigned char* const wsl = wsp(p); (void)wsl; __VA_ARGS__; } if (MEGA) { for (int _s = 0; _s < REP_SYNC; ++_s) { if (p.njobs < 0) grid.sync(); xcd_barrier(xb); } } ++idx; } while (0)
#define PHR(REP, ...) _Pragma("unroll 1") for (int rep = 0; rep < (REP); ++rep) { float* const xo = (rep == (REP) - 1) ? p.out : (float*)(p.ws + OFF_QN); (void)xo; PH(__VA_ARGS__); }
template <bool MEGA, int layer>
DI void run_layer(const Params& p, LAS unsigned char* lds, int& idx, const int phase, const XcdBarrier& xb, cg::grid_group& grid) {
    constexpr int kind = layer % 3, j = layer / 3;
        const float* gmix = p.norm_mix_g + layer * D;
    unsigned char* const wsl0 = wsp(p); (void)wsl0;
        if constexpr (kind == 0) {
            const void* xin = layer == 0 ? (const void*)p.x_in : (const void*)(wsl0 + OFF_XB);
            if constexpr (layer != 0) { PHR(REP_MISC, if (EN(1)) rstd_phase<true>(p, xin)); }
            PHR(REP_MISC, if (EN(2)) pool_phase<layer != 0>(p, xin, gmix));
            PHR(REP_GEMM, if (EN(3)) { MapPool mp{(const bf16_t*)(wsl + OFF_H), (const bf16_t*)(wsl + OFF_WPOOL) + (size_t)j * 4 * 512 * 512}; EpiRes<layer != 0, true> ep{xin, wsl + OFF_XB, p.pool_scale + j * D};
                 gemm_phase(lds, mp, ep, 64, 8, 512, 2048, 512); });
        } else if constexpr (kind == 1) {
            PHR(REP_MISC, if (EN(4)) norm_phase<true>(p, wsl + OFF_XB, gmix));
            PHR(REP_GEMM, if (EN(5)) { MapPlain mp{(const bf16_t*)(wsl + OFF_H), (const bf16_t*)(wsl + OFF_WQKV), 2048, 2048}; EpiBf16 ep{(bf16_t*)(wsl + OFF_QKV32), 2560, nullptr, 0, 1 << 30};
                 gemm_phase(lds, mp, ep, 64, 10, 2048, 2048, 2048); });
            PHR(REP_MISC, if (EN(6)) swa_prep_phase(p));
            PHR(REP_ATTN, if (EN(7)) swa_attn_phase(p, lds));
            PHR(REP_GEMM, if (EN(8)) { MapPlain mp{(const bf16_t*)(wsl + OFF_H), (const bf16_t*)(wsl + OFF_WSWAO), 2048, 2048}; EpiRes<true, true> ep{wsl + OFF_XB, wsl + OFF_XB, nullptr};
                 gemm_phase(lds, mp, ep, 64, 8, 2048, 2048, 2048); });
        } else {
            PHR(REP_MISC, if (EN(9)) norm_phase<true>(p, wsl + OFF_XB, gmix));
            PHR(REP_GEMM, if (EN(10)) { MapPlain mp{(const bf16_t*)(wsl + OFF_H), (const bf16_t*)(wsl + OFF_WDOWN), 2048, 2048}; EpiBf16 ep{(bf16_t*)(wsl + OFF_D32), 1280, nullptr, 0, 1 << 30};
                 gemm_phase(lds, mp, ep, 64, 5, 2048, 2048, 2048); });
            PHR(REP_MISC, if (EN(11)) mla_prep1_phase(p));
            PHR(REP_GEMM, if (EN(12)) { MapUqkv mp{(const bf16_t*)(wsl + OFF_CQ), (const bf16_t*)(wsl + OFF_CKV), (const bf16_t*)(wsl + OFF_WUQ), (const bf16_t*)(wsl + OFF_WUKV)};
                 EpiBf16 ep{(bf16_t*)(wsl + OFF_Q32), 3072, (bf16_t*)(wsl + OFF_KV32), 4096, 12};
                 gemm_phase(lds, mp, ep, 64, 28, 512, 512, 512); });
            PHR(REP_MISC, if (EN(13)) mla_prep2_phase(p));
            PHR(REP_ATTN, if (EN(14)) mla_attn_phase(p, lds));
            PHR(REP_GEMM, if (EN(15)) { MapPlain mp{(const bf16_t*)(wsl + OFF_H), (const bf16_t*)(wsl + OFF_WMLAO), 2048, 2048}; EpiRes<true, true> ep{wsl + OFF_XB, wsl + OFF_XB, nullptr};
                 gemm_phase(lds, mp, ep, 64, 8, 2048, 2048, 2048); });
        }
        PHR(REP_MISC, if (EN(16)) norm_phase<true>(p, wsl + OFF_XB, p.norm_ffn_g + layer * D));
        PHR(REP_GEMM, if (EN(17)) { MapPlain mp{(const bf16_t*)(wsl + OFF_H), (const bf16_t*)(wsl + OFF_WFIN) + (size_t)layer * 11264 * 2048, 2048, 2048};
             EpiGlu ep{p.ffn_conv_w + (size_t)layer * 3 * DFF, p.ffn_conv_b + (size_t)layer * DFF, (bf16_t*)(wsl + OFF_ACT), (float*)(wsl + OFF_EP), (float*)(wsl + OFF_ER), (float*)(wsl + OFF_EV)};
             gemm_phase(lds, mp, ep, 64, 44, 2048, 2048, 2048); });
        PHR(REP_MISC, if (EN(18)) glu_fix_phase(p, layer));
        PHR(REP_GEMM, if (EN(19)) { MapPlain mp{(const bf16_t*)(wsl + OFF_ACT), (const bf16_t*)(wsl + OFF_WFOUT) + (size_t)layer * 2048 * 5632, 5632, 5632}; EpiRes<true, layer != 3> ep{wsl + OFF_XB, layer == 3 ? (void*)p.out : (void*)(wsl + OFF_XB), nullptr};
             gemm_phase(lds, mp, ep, 64, 8, 5632, 5632, 5632); });
}

template <bool MEGA>
__global__ void __launch_bounds__(512) fwd_kernel(Params p, int phase) {
    extern __shared__ __attribute__((aligned(16))) unsigned char lds_raw[];
    LAS unsigned char* lds = (LAS unsigned char*)lds_raw;
    cg::grid_group grid = cg::this_grid();
    int idx = 0;
    volatile LAS unsigned* xst = (volatile LAS unsigned*)(lds + LDS_STAGE);
    if (threadIdx.x == 0) { xst[0] = 0u; xst[1] = 0u; xst[2] = 0u; xst[3] = 0u; }
    __syncthreads();
    const XcdBarrier xb = xcd_barrier_post((unsigned*)(p.ws + OFF_BAR), xst);
    PHR(REP_MISC, if (EN(0)) convert_phase(p, lds); rstd_phase<false>(p, p.x_in));
    run_layer<MEGA, 0>(p, lds, idx, phase, xb, grid);
    run_layer<MEGA, 1>(p, lds, idx, phase, xb, grid);
    run_layer<MEGA, 2>(p, lds, idx, phase, xb, grid);
    run_layer<MEGA, 3>(p, lds, idx, phase, xb, grid);
#undef PH
#undef PHR
}

__global__ void nan_fill(float* out, int n) { for (int i = blockIdx.x * blockDim.x + threadIdx.x; i < n; i += gridDim.x * blockDim.x) out[i] = __uint_as_float(0x7fc00000u); }

extern "C" void kernel_launch(void* const* d_in, const int* in_sizes, int n_in, void* d_out, int out_size, void* d_ws, size_t ws_size, hipStream_t stream) {
    if (ws_size < WS_END || n_in < 25) { fprintf(stderr, "kernel_launch: workspace too small (%zu < %zu) or bad n_in %d\n", ws_size, (size_t)WS_END, n_in);
        nan_fill<<<256, 256, 0, stream>>>((float*)d_out, out_size); return; }
    Params p{};
    p.x_in = (const float*)d_in[0]; p.positions = (const int*)d_in[1]; p.norm_mix_g = (const float*)d_in[2]; p.norm_ffn_g = (const float*)d_in[3];
    p.pool_scale = (const float*)d_in[5]; p.swa_q_gain = (const float*)d_in[7]; p.swa_k_gain = (const float*)d_in[8]; p.swa_sinks = (const float*)d_in[9];
    p.mla_q_a_gain = (const float*)d_in[12]; p.mla_kv_a_gain = (const float*)d_in[13]; p.mla_qn_gain = (const float*)d_in[16]; p.mla_qr_gain = (const float*)d_in[17];
    p.mla_kn_gain = (const float*)d_in[18]; p.mla_kr_gain = (const float*)d_in[19]; p.ffn_conv_w = (const float*)d_in[22]; p.ffn_conv_b = (const float*)d_in[23];
    p.out = (float*)d_out; p.ws = (unsigned char*)d_ws;
    unsigned char* ws = (unsigned char*)d_ws; int nj = 0;
    auto add = [&](const float* src, size_t off, int K, int N, int mode = 0) { p.jobs[nj].src = src; p.jobs[nj].dst = (bf16_t*)(ws + off); p.jobs[nj].K = K; p.jobs[nj].N = N; p.jobs[nj].mode = mode; ++nj; };
    for (int g = 0; g < 8; ++g) add((const float*)d_in[4] + (size_t)g * 512 * 512, OFF_WPOOL + (size_t)g * 512 * 512 * 2, 512, 512);
    add((const float*)d_in[6], OFF_WQKV, 2048, 2560);
    add((const float*)d_in[10], OFF_WSWAO, 2048, 2048);
    add((const float*)d_in[11], OFF_WDOWN, 2048, 1088);
    add((const float*)d_in[14], OFF_WUQ, 512, 3072);
    add((const float*)d_in[15], OFF_WUKV, 512, 4096);
    add((const float*)d_in[20], OFF_WMLAO, 2048, 2048);
    for (int i = 0; i < 4; ++i) add((const float*)d_in[21] + (size_t)i * 2048 * 11264, OFF_WFIN + (size_t)i * 11264 * 2048 * 2, 2048, 11264, 1);
    for (int i = 0; i < 4; ++i) add((const float*)d_in[24] + (size_t)i * 5632 * 2048, OFF_WFOUT + (size_t)i * 2048 * 5632 * 2, 5632, 2048);
    p.njobs = nj;
    static int grid_blocks = 0;
    if (!grid_blocks) {
        int dev = 0, cus = 0, per_cu = 0;
        (void)hipGetDevice(&dev); (void)hipDeviceGetAttribute(&cus, hipDeviceAttributeMultiprocessorCount, dev);
        (void)hipFuncSetAttribute((const void*)fwd_kernel<MEGA_MODE != 0>, hipFuncAttributeMaxDynamicSharedMemorySize, LDS_BYTES);
        (void)hipOccupancyMaxActiveBlocksPerMultiprocessor(&per_cu, (const void*)fwd_kernel<MEGA_MODE != 0>, 512, LDS_BYTES);
        if (per_cu < 1) per_cu = 1;
        if (per_cu > 1) per_cu = 1;
        if (cus < 1) cus = 256;
        grid_blocks = cus * per_cu; (void)hipGetLastError();
    }
    (void)hipMemsetAsync((unsigned char*)d_ws + OFF_BAR, 0, 16384, stream);
#if MEGA_MODE
    int ph = -1; void* args[] = {&p, &ph};
    hipError_t e = hipLaunchCooperativeKernel((const void*)fwd_kernel<true>, dim3(grid_blocks), dim3(512), args, LDS_BYTES, stream);
    if (e != hipSuccess) fprintf(stderr, "cooperative launch failed: %s (grid %d)\n", hipGetErrorString(e), grid_blocks);
#else
    for (int ph = 0; ph < NPHASES; ++ph) hipLaunchKernelGGL(fwd_kernel<false>, dim3(grid_blocks), dim3(512), LDS_BYTES, stream, p, ph);
#endif
}
```
